# Optimizing an MI355X kernel written in HIP

```python
import jax, jax.numpy as jnp
from jax import lax
import numpy as np

D_MODEL = 1024
BATCH = 16
SEQ = 2048
DEPTH = 4

N_A = DEPTH // 2
N_B = DEPTH - N_A

GLA_HEADS = 4
GLA_QK = D_MODEL // 2
GLA_V = D_MODEL
GLA_HEAD_K = GLA_QK // GLA_HEADS
GLA_HEAD_V = GLA_V // GLA_HEADS
GATE_RANK = 16
GATE_TAU = 16.0
GLA_CHUNK = 64
GLA_IN = 2 * GLA_QK + 2 * GLA_V + GATE_RANK

SB_HEADS = 16
SB_HEAD_DIM = D_MODEL // SB_HEADS
BLOCK_Q = 128

D_FF = 4 * D_MODEL

DEEPNORM_ALPHA = (2.0 * DEPTH) ** 0.25
DEEPNORM_BETA = (8.0 * DEPTH) ** -0.25
LN_EPS = 1e-5
RMS_EPS = 1e-6

kernel_name = "yoco_gla_stickbreaking_deepnorm"


def layer_norm(x, g, b):
    xf = x.astype(jnp.float32)
    mu = jnp.mean(xf, axis=-1, keepdims=True)
    var = jnp.mean(jnp.square(xf - mu), axis=-1, keepdims=True)
    y = (xf - mu) * lax.rsqrt(var + LN_EPS)
    return (y * g.astype(jnp.float32) + b.astype(jnp.float32)).astype(x.dtype)


def gla_chunked(q, k, v, log_a):
    B, S, H, dk = q.shape
    dv = v.shape[-1]
    n = S // GLA_CHUNK

    def to_chunks(t):
        return t.astype(jnp.float32).reshape(B, n, GLA_CHUNK, H, t.shape[-1]).transpose(0, 3, 1, 2, 4)

    qc = to_chunks(q) * (dk ** -0.5)
    kc = to_chunks(k)
    vc = to_chunks(v)
    b = jnp.cumsum(to_chunks(log_a), axis=3)
    b_last = b[:, :, :, -1:, :]
    q_dec = qc * jnp.exp(b)
    k_dec = kc * jnp.exp(-b)
    k_end = kc * jnp.exp(b_last - b)

    causal = jnp.tril(jnp.ones((GLA_CHUNK, GLA_CHUNK), dtype=bool))
    att = jnp.where(causal, jnp.einsum('bhncd,bhnsd->bhncs', q_dec, k_dec), 0.0)
    o_intra = jnp.einsum('bhncs,bhnse->bhnce', att, vc)

    u = jnp.einsum('bhnsd,bhnse->bhnde', k_end, vc)
    decay = jnp.exp(b_last[:, :, :, 0, :])

    def step(state, inp):
        d_n, u_n = inp
        return d_n[..., None] * state + u_n, state

    init = jnp.zeros((B, H, dk, dv), jnp.float32)
    _, s_prev = lax.scan(step, init, (jnp.moveaxis(decay, 2, 0), jnp.moveaxis(u, 2, 0)))
    s_prev = jnp.moveaxis(s_prev, 0, 2)
    o_inter = jnp.einsum('bhncd,bhnde->bhnce', q_dec, s_prev)
    o = o_intra + o_inter
    return o.transpose(0, 2, 3, 1, 4).reshape(B, S, H, dv)


def gla_mixer(x, w_in, w_a2, b_a, norm_g, w_o):
    B, S, _ = x.shape
    proj = x @ w_in
    q, k, v, g, a1 = jnp.split(
        proj, [GLA_QK, 2 * GLA_QK, 2 * GLA_QK + GLA_V, 2 * GLA_QK + 2 * GLA_V], axis=-1)
    log_a = jax.nn.log_sigmoid((a1 @ w_a2 + b_a).astype(jnp.float32)) / GATE_TAU
    hk = lambda t: t.reshape(B, S, GLA_HEADS, GLA_HEAD_K)
    o = gla_chunked(hk(q), hk(k), v.reshape(B, S, GLA_HEADS, GLA_HEAD_V), hk(log_a))
    o = o * lax.rsqrt(jnp.mean(jnp.square(o), axis=-1, keepdims=True) + RMS_EPS)
    o = o * norm_g.astype(jnp.float32)
    o = o * jax.nn.silu(g.astype(jnp.float32).reshape(B, S, GLA_HEADS, GLA_HEAD_V))
    return o.reshape(B, S, GLA_V).astype(x.dtype) @ w_o


def stick_breaking_attention(q, k, v):
    S = q.shape[1]
    scale = SB_HEAD_DIM ** -0.5
    outs = []
    for i in range(S // BLOCK_Q):
        kv_len = (i + 1) * BLOCK_Q
        q_blk = q[:, i * BLOCK_Q:kv_len].astype(jnp.float32)
        k_blk = k[:, :kv_len].astype(jnp.float32)
        v_blk = v[:, :kv_len].astype(jnp.float32)
        z = jnp.einsum('bqhd,bkhd->bhqk', q_blk, k_blk) * scale
        t_idx = i * BLOCK_Q + jnp.arange(BLOCK_Q)
        s_idx = jnp.arange(kv_len)
        mask = s_idx[None, :] < t_idx[:, None]
        log_1m = jnp.where(mask, jax.nn.log_sigmoid(-z), 0.0)
        rev = lax.cumsum(log_1m, axis=3, reverse=True)
        log_w = jax.nn.log_sigmoid(z) + (rev - log_1m)
        w = jnp.where(mask, jnp.exp(log_w), 0.0)
        outs.append(jnp.einsum('bhqk,bkhd->bqhd', w, v_blk))
    return jnp.concatenate(outs, axis=1)


def sq_relu_mlp(x, w_up, w_down):
    h = jax.nn.relu(x @ w_up)
    return (h * h) @ w_down


def setup_inputs(seed: int = 0) -> dict:
    key = jax.random.key(seed)
    ks = jax.random.split(key, 16)
    nrm = lambda k, shape, s: jax.random.normal(k, shape, jnp.float32) * s
    return {
        "x": nrm(ks[0], (BATCH, SEQ, D_MODEL), 1.0),
        "gla_w_in": nrm(ks[1], (N_A, D_MODEL, GLA_IN), D_MODEL ** -0.5),
        "gla_w_a2": nrm(ks[2], (N_A, GATE_RANK, GLA_QK), GATE_RANK ** -0.5),
        "gla_b_a": nrm(ks[3], (N_A, GLA_QK), 0.1),
        "gla_norm_g": 1.0 + nrm(ks[4], (N_A, GLA_HEAD_V), 0.02),
        "gla_w_o": nrm(ks[5], (N_A, GLA_V, D_MODEL), GLA_V ** -0.5 * DEEPNORM_BETA),
        "kv_w": nrm(ks[6], (D_MODEL, 2 * D_MODEL), D_MODEL ** -0.5),
        "sb_w_q": nrm(ks[7], (N_B, D_MODEL, D_MODEL), D_MODEL ** -0.5),
        "sb_w_o": nrm(ks[8], (N_B, D_MODEL, D_MODEL), D_MODEL ** -0.5 * DEEPNORM_BETA),
        "mlp_w_up": nrm(ks[9], (DEPTH, D_MODEL, D_FF), D_MODEL ** -0.5),
        "mlp_w_down": nrm(ks[10], (DEPTH, D_FF, D_MODEL), D_FF ** -0.5 * DEEPNORM_BETA),
        "ln_g": 1.0 + nrm(ks[11], (DEPTH, 2, D_MODEL), 0.02),
        "ln_b": nrm(ks[12], (DEPTH, 2, D_MODEL), 0.02),
    }


def reference(x, gla_w_in, gla_w_a2, gla_b_a, gla_norm_g, gla_w_o, kv_w, sb_w_q, sb_w_o,
              mlp_w_up, mlp_w_down, ln_g, ln_b):
    B, S, D = x.shape
    h = x
    k_sh = None
    v_sh = None
    for layer in range(DEPTH):
        if layer < N_A:
            mix = gla_mixer(h, gla_w_in[layer], gla_w_a2[layer], gla_b_a[layer],
                            gla_norm_g[layer], gla_w_o[layer])
        else:
            j = layer - N_A
            if j == 0:
                kv = h @ kv_w
                k_sh = kv[..., :D].reshape(B, S, SB_HEADS, SB_HEAD_DIM)
                v_sh = kv[..., D:].reshape(B, S, SB_HEADS, SB_HEAD_DIM)
            q = (h @ sb_w_q[j]).reshape(B, S, SB_HEADS, SB_HEAD_DIM)
            o = stick_breaking_attention(q, k_sh, v_sh)
            mix = o.reshape(B, S, D).astype(h.dtype) @ sb_w_o[j]
        h = layer_norm(DEEPNORM_ALPHA * h + mix, ln_g[layer, 0], ln_b[layer, 0])
        h = layer_norm(DEEPNORM_ALPHA * h + sq_relu_mlp(h, mlp_w_up[layer], mlp_w_down[layer]),
                       ln_g[layer, 1], ln_b[layer, 1])
    return h
```

```cpp
#include <hip/hip_runtime.h>
#include <hip/hip_cooperative_groups.h>
#include <cstdio>
#include <cstdint>
namespace cg = cooperative_groups;
namespace pg8 {
#define PG8_LAS __attribute__((address_space(3)))
typedef unsigned short bf16_t;
typedef short bf16x8 __attribute__((ext_vector_type(8)));
typedef float f32x4 __attribute__((ext_vector_type(4)));
typedef unsigned u32x4 __attribute__((ext_vector_type(4)));
constexpr int BM = 256, BK = 64, HALF = 128, HTB = HALF * BK * 2  , STAGE_BYTES = 8 * HTB, NXCD = 8, WGM = 8;

__host__ __device__ __forceinline__ int lds_byte(int r, int c) { const int st = (r >> 4) * 2 + (c >> 5), rr = r & 15, cc = c & 31, ob = rr * 64 + cc * 2; return st * 1024 + (ob ^ (((ob >> 9) & 1) << 5)); }
__host__ __device__ __forceinline__ void stage_rc(int b, int& R, int& C) { const int st = b / 1024, sb = b % 1024, swz = sb ^ (((sb >> 9) & 1) << 5); R = (st >> 1) * 16 + swz / 64; C = (st & 1) * 32 + (swz % 64) / 2; }
__host__ __device__ __forceinline__ int perm32(int rho) { const int n = rho >> 4, i = rho & 15; return 8 * (i >> 2) + 4 * n + (i & 3); }

struct Unit { int pm, pn; };
struct Gemm { const bf16_t* A; const bf16_t* Bt; int M, N, K; };

struct StaticOrder {
    int nM, nN, nwg, G, c;
    __host__ __device__ void init(int M, int N, int G_, int c_) { nM = M / BM; nN = N / BM; nwg = nM * nN; G = G_; c = c_; }
    __host__ __device__ bool next(int i, Unit& u) const {
        const long L = (long)i * G + c; if (L >= nwg) return false;
        int wgid = (int)L; { const int q = nwg / NXCD, r = nwg % NXCD, xcd = wgid % NXCD, off = wgid / NXCD; wgid = (xcd < r ? xcd * (q + 1) : r * (q + 1) + (xcd - r) * q) + off; }
        const int nig = WGM * nN, gid = wgid / nig, fm = gid * WGM, gsz = (nM - fm) < WGM ? (nM - fm) : WGM;
        u.pm = fm + ((wgid % nig) % gsz); u.pn = (wgid % nig) / gsz; return true;
    }
    __device__ __forceinline__ void a_ready(const Unit&) const {}
    __device__ __forceinline__ void done(const Unit&) const {}
};

__device__ __forceinline__ unsigned cvt_pk_bf16(float lo, float hi) { unsigned r; asm volatile("v_cvt_pk_bf16_f32 %0, %1, %2" : "=v"(r) : "v"(lo), "v"(hi)); return r; }
typedef float f32x2 __attribute__((ext_vector_type(2)));
__device__ __forceinline__ f32x2 gelu_pk(f32x2 v) {
    const f32x2 av = __builtin_elementwise_abs(v), d = av * 0.2316418882f + 1.0f;
    f32x2 t; t.x = __builtin_amdgcn_rcpf(d.x); t.y = __builtin_amdgcn_rcpf(d.y);
    f32x2 q = t * 0.5307027145f + (-0.7265760135f); q = q * t + 0.7107068705f; q = q * t + (-0.142248368f); q = q * t + 0.127414796f; q = q * t;
    const f32x2 s = (v * v) * (-0.72134752044f);
    f32x2 e; e.x = __builtin_amdgcn_exp2f(s.x); e.y = __builtin_amdgcn_exp2f(s.y);
    const f32x2 m = v * (q * e), r = v - m;
    f32x2 o; o.x = v.x < 0.f ? m.x : r.x; o.y = v.y < 0.f ? m.y : r.y; return o;
}

template <int ACT  > struct EpiBf16 {
    static constexpr bool PERM = true, AFTER_DRAIN = false; static_assert(ACT == 0 || ACT == 1, "EpiBf16: ACT is 0 (none) or 1 (gelu_pk)");
    bf16_t* O; int ldc; const float* bias; int split_cols; size_t split_stride; float scale0;
    __device__ __forceinline__ void operator()(const f32x4 (&acc)[2][2][4][2], const Unit& u, int wr, int wc, int fr, int fq) const {
        const int row0 = u.pm * BM + wr * 64 + fr; int colt = u.pn * BM; bf16_t* base = O;
        float sc = 1.f; if (split_cols) { const int t = colt / split_cols; base += (size_t)t * split_stride; colt -= t * split_cols; if (t == 0) sc = scale0; }
        const int col0 = colt + wc * 32 + 8 * fq, bcol0 = u.pn * BM + wc * 32 + 8 * fq;
        f32x4 bv[2][2];
#pragma unroll
        for (int bj = 0; bj < 2; ++bj)
#pragma unroll
            for (int n = 0; n < 2; ++n) bv[bj][n] = bias ? *(const f32x4*)(bias + bcol0 + bj * HALF + 4 * n) : (f32x4){0.f, 0.f, 0.f, 0.f};
#pragma unroll
        for (int ai = 0; ai < 2; ++ai)
#pragma unroll
            for (int m = 0; m < 4; ++m) { bf16_t* rowp = base + (size_t)(row0 + ai * HALF + m * 16) * ldc + col0;
#pragma unroll
                for (int bj = 0; bj < 2; ++bj) { f32x4 v0 = acc[ai][bj][m][0] + bv[bj][0], v1 = acc[ai][bj][m][1] + bv[bj][1];
                    if (ACT == 1) { f32x2 a = gelu_pk((f32x2){v0[0], v0[1]}), b = gelu_pk((f32x2){v0[2], v0[3]}), c = gelu_pk((f32x2){v1[0], v1[1]}), d = gelu_pk((f32x2){v1[2], v1[3]});
                        v0 = (f32x4){a.x, a.y, b.x, b.y}; v1 = (f32x4){c.x, c.y, d.x, d.y}; }
                    v0 = v0 * sc; v1 = v1 * sc; u32x4 w; w.x = cvt_pk_bf16(v0[0], v0[1]); w.y = cvt_pk_bf16(v0[2], v0[3]); w.z = cvt_pk_bf16(v1[0], v1[1]); w.w = cvt_pk_bf16(v1[2], v1[3]);
                    *(u32x4*)(rowp + bj * HALF) = w; } }
    }
};

struct PanelStats {
    unsigned* xbuf;
    unsigned* cnt;
    unsigned* tmo;
    int ntn; float eps;
    unsigned code;
    __device__ __forceinline__ bool run(const f32x4 (&v)[2][2][4][2], const Unit& u, int wr, int wc, int fr, int fq, PG8_LAS unsigned char* lds, int wid, int lane) const {
        typedef float f32x2v __attribute__((ext_vector_type(2)));
        PG8_LAS f32x2v* P = (PG8_LAS f32x2v*)lds;
        PG8_LAS f32x2v* S = (PG8_LAS f32x2v*)(lds + 8192);
        PG8_LAS unsigned* flag = (PG8_LAS unsigned*)(lds + 8192 + 2048);
#pragma unroll
        for (int ai = 0; ai < 2; ++ai)
#pragma unroll
            for (int m = 0; m < 4; ++m) {
                float s = 0.f;
#pragma unroll
                for (int bj = 0; bj < 2; ++bj)
#pragma unroll
                    for (int n = 0; n < 2; ++n) { const f32x4 x = v[ai][bj][m][n]; s += (x[0] + x[1]) + (x[2] + x[3]); }
                s += __shfl_xor(s, 16); s += __shfl_xor(s, 32);
                const float mw = s * (1.0f / 64.0f); float q = 0.f;
#pragma unroll
                for (int bj = 0; bj < 2; ++bj)
#pragma unroll
                    for (int n = 0; n < 2; ++n) { const f32x4 d = v[ai][bj][m][n] - mw; q += (d[0] * d[0] + d[1] * d[1]) + (d[2] * d[2] + d[3] * d[3]); }
                q += __shfl_xor(q, 16); q += __shfl_xor(q, 32);
                if (fq == 0) P[(ai * HALF + wr * 64 + m * 16 + fr) * 4 + wc] = (f32x2v){mw, q};
            }
        asm volatile("s_waitcnt lgkmcnt(0)" ::: "memory"); __builtin_amdgcn_s_barrier(); asm volatile("" ::: "memory");
#if defined(BROKEN_EXCHANGE_NO_WAIT)
#warning BROKEN CONTROL BUILD: the row-statistics exchange does not wait; results are wrong by design
        if (blockIdx.x >= 64) { const long long t0_ = clock64(); while (clock64() - t0_ < 60000) __builtin_amdgcn_s_sleep(8); }
#endif
        const int row = wid * 32 + (lane & 31);
        if (lane < 32) {
            const f32x2v a = P[row * 4 + 0], b = P[row * 4 + 1], c = P[row * 4 + 2], d = P[row * 4 + 3];
            const float mt = (a.x + b.x + c.x + d.x) * 0.25f;
            const float da = a.x - mt, db = b.x - mt, dc = c.x - mt, dd = d.x - mt;
            const float m2 = (a.y + b.y) + (c.y + d.y) + 64.0f * ((da * da + db * db) + (dc * dc + dd * dd));
            unsigned long long* slot = (unsigned long long*)xbuf + ((size_t)(u.pm * BM + row) * 4 + u.pn);
            __hip_atomic_store(slot, ((unsigned long long)__float_as_uint(m2) << 32) | __float_as_uint(mt), __ATOMIC_RELAXED, __HIP_MEMORY_SCOPE_AGENT);
        }
        asm volatile("s_waitcnt vmcnt(0)" ::: "memory");
        if (lane == 0) __hip_atomic_fetch_add(cnt + 64 * u.pm, 1u, __ATOMIC_RELAXED, __HIP_MEMORY_SCOPE_AGENT);
        if (wid == 0) {
            bool dead = false; const unsigned long long t0 = __builtin_amdgcn_s_memrealtime(); const unsigned want = 8u * (unsigned)ntn;
            for (;;) {
#if defined(BROKEN_EXCHANGE_NO_WAIT)
                break;
#endif
                if ((unsigned)__builtin_amdgcn_readfirstlane(__hip_atomic_load(cnt + 64 * u.pm, __ATOMIC_RELAXED, __HIP_MEMORY_SCOPE_AGENT)) >= want) break;
                if (__builtin_amdgcn_s_memrealtime() - t0 > 2000000ull) {
                    if (lane == 0) { unsigned expect = 0u; __hip_atomic_compare_exchange_strong(tmo + 1, &expect, code | (unsigned)(u.pm & 0xff), __ATOMIC_RELAXED, __ATOMIC_RELAXED, __HIP_MEMORY_SCOPE_AGENT);
                                     __hip_atomic_store(tmo, 1u, __ATOMIC_RELAXED, __HIP_MEMORY_SCOPE_AGENT); }
                    dead = true; break; }
                __builtin_amdgcn_s_sleep(2);
            }
            __builtin_amdgcn_fence(__ATOMIC_ACQUIRE, "agent");
            if (lane == 0) flag[0] = dead ? 1u : 0u;
        }
        asm volatile("s_waitcnt vmcnt(0) lgkmcnt(0)" ::: "memory"); __builtin_amdgcn_s_barrier(); asm volatile("" ::: "memory");
        const bool bad = flag[0] != 0u;
        if (lane < 32) {
            const unsigned long long* slot = (const unsigned long long*)xbuf + (size_t)(u.pm * BM + row) * 4; float mt[4], m2[4]; float ms = 0.f;
#pragma unroll
            for (int t = 0; t < 4; ++t) { if (t < ntn) { const unsigned long long w = __hip_atomic_load(slot + t, __ATOMIC_RELAXED, __HIP_MEMORY_SCOPE_AGENT); mt[t] = __uint_as_float((unsigned)w); m2[t] = __uint_as_float((unsigned)(w >> 32)); } else { mt[t] = 0.f; m2[t] = 0.f; } ms += mt[t]; }
            const float mean = ms / (float)ntn; float q = 0.f;
#pragma unroll
            for (int t = 0; t < 4; ++t) if (t < ntn) { const float dm = mt[t] - mean; q += m2[t] + 256.0f * dm * dm; }
            S[row] = (f32x2v){mean, 1.0f / sqrtf(q / (256.0f * (float)ntn) + eps)};
        }
        asm volatile("s_waitcnt lgkmcnt(0)" ::: "memory"); __builtin_amdgcn_s_barrier(); asm volatile("" ::: "memory");
        return bad;
    }
};
struct EpiLnRes {
    static constexpr bool PERM = false, AFTER_DRAIN = true;
    const float* base; float* out; int ldc; const float* bias; PanelStats st; unsigned poison;
    __device__ __forceinline__ void fused(f32x4 (&acc)[2][2][4][2], const Unit& u, int wr, int wc, int fr, int fq, PG8_LAS unsigned char* lds, int wid, int lane) const {
        typedef float f32x2v __attribute__((ext_vector_type(2)));
        const PG8_LAS f32x2v* S = (const PG8_LAS f32x2v*)(lds + 8192);
        const int col0 = u.pn * BM + wc * 32 + 4 * fq;
#pragma unroll
        for (int bj = 0; bj < 2; ++bj)
#pragma unroll
            for (int n = 0; n < 2; ++n) { const f32x4 bv = bias ? *(const f32x4*)(bias + col0 + bj * HALF + n * 16) : (f32x4){0.f, 0.f, 0.f, 0.f};
#pragma unroll
                for (int ai = 0; ai < 2; ++ai)
#pragma unroll
                    for (int m = 0; m < 4; ++m) acc[ai][bj][m][n] += bv; }
        f32x4 pre[4][2][2];
#pragma unroll
        for (int m = 0; m < 4; ++m) { const size_t off = (size_t)(u.pm * BM + wr * 64 + m * 16 + fr) * ldc + col0;
#pragma unroll
            for (int bj = 0; bj < 2; ++bj)
#pragma unroll
                for (int n = 0; n < 2; ++n) pre[m][bj][n] = *(const f32x4*)(base + off + bj * HALF + n * 16); }
        const bool bad = st.run(acc, u, wr, wc, fr, fq, lds, wid, lane) || poison != 0u;
        const float qnan = __builtin_nanf("");
#pragma unroll
        for (int ai = 0; ai < 2; ++ai)
#pragma unroll
            for (int m = 0; m < 4; ++m) { const int r = ai * HALF + wr * 64 + m * 16 + fr; const f32x2v sr = S[r]; const size_t off = (size_t)(u.pm * BM + r) * ldc + col0;
#pragma unroll
                for (int bj = 0; bj < 2; ++bj)
#pragma unroll
                    for (int n = 0; n < 2; ++n) { const f32x4 bs = ai == 0 ? pre[m][bj][n] : *(const f32x4*)(base + off + bj * HALF + n * 16); f32x4 o = bs + (acc[ai][bj][m][n] - sr.x) * sr.y;
                        if (bad) o = (f32x4){qnan, qnan, qnan, qnan}; *(f32x4*)(out + off + bj * HALF + n * 16) = o; }
                if (m & 1) asm volatile("" ::: "memory"); }
    }
};
struct EpiLnResLn {
    static constexpr bool PERM = false, AFTER_DRAIN = true;
    const float* base; float* out; bf16_t* xn; int ldc; const float* bias; PanelStats st1, st2; unsigned poison;
    __device__ __forceinline__ void fused(f32x4 (&acc)[2][2][4][2], const Unit& u, int wr, int wc, int fr, int fq, PG8_LAS unsigned char* lds, int wid, int lane) const {
        typedef float f32x2v __attribute__((ext_vector_type(2))); typedef unsigned u32x2v __attribute__((ext_vector_type(2)));
        const PG8_LAS f32x2v* S = (const PG8_LAS f32x2v*)(lds + 8192);
        const int col0 = u.pn * BM + wc * 32 + 4 * fq;
#pragma unroll
        for (int bj = 0; bj < 2; ++bj)
#pragma unroll
            for (int n = 0; n < 2; ++n) { const f32x4 bv = bias ? *(const f32x4*)(bias + col0 + bj * HALF + n * 16) : (f32x4){0.f, 0.f, 0.f, 0.f};
#pragma unroll
                for (int ai = 0; ai < 2; ++ai)
#pragma unroll
                    for (int m = 0; m < 4; ++m) acc[ai][bj][m][n] += bv; }
        bool bad = st1.run(acc, u, wr, wc, fr, fq, lds, wid, lane) || poison != 0u;
        const float qnan = __builtin_nanf("");
#pragma unroll
        for (int ai = 0; ai < 2; ++ai)
#pragma unroll
            for (int m = 0; m < 4; ++m) { const int r = ai * HALF + wr * 64 + m * 16 + fr; const f32x2v sr = S[r]; const size_t off = (size_t)(u.pm * BM + r) * ldc + col0;
#pragma unroll
                for (int bj = 0; bj < 2; ++bj)
#pragma unroll
                    for (int n = 0; n < 2; ++n) { const f32x4 bs = *(const f32x4*)(base + off + bj * HALF + n * 16); acc[ai][bj][m][n] = bs + (acc[ai][bj][m][n] - sr.x) * sr.y; }
                asm volatile("" : "+v"(acc[ai][0][m][0]), "+v"(acc[ai][0][m][1]), "+v"(acc[ai][1][m][0]), "+v"(acc[ai][1][m][1]));
                if (m & 1) asm volatile("" ::: "memory"); }
        const bool bad1 = bad;
        bad = st2.run(acc, u, wr, wc, fr, fq, lds, wid, lane) || bad;
#pragma unroll
        for (int ai = 0; ai < 2; ++ai)
#pragma unroll
            for (int m = 0; m < 4; ++m) { const int r = ai * HALF + wr * 64 + m * 16 + fr; const f32x2v sr = S[r]; const size_t off = (size_t)(u.pm * BM + r) * ldc + col0;
#pragma unroll
                for (int bj = 0; bj < 2; ++bj)
#pragma unroll
                    for (int n = 0; n < 2; ++n) { const f32x4 x1 = acc[ai][bj][m][n]; *(f32x4*)(out + off + bj * HALF + n * 16) = bad1 ? (f32x4){qnan, qnan, qnan, qnan} : x1;
                        const f32x4 o = (x1 - sr.x) * sr.y; u32x2v w; w.x = cvt_pk_bf16(o[0], o[1]); w.y = cvt_pk_bf16(o[2], o[3]);
                        if (bad) { w.x = 0x7fc07fc0u; w.y = 0x7fc07fc0u; } *(u32x2v*)(xn + off + bj * HALF + n * 16) = w; }
                asm volatile("" ::: "memory"); }
    }
};

template <class Epi, class Sched, bool ALIGN_EPI = false, bool SP2 = false>
__device__ __forceinline__ void gemm_phase(PG8_LAS unsigned char* lds, const Gemm g, const Sched& S, const Epi& E) {
    const int tid = threadIdx.x, wid = __builtin_amdgcn_readfirstlane(tid >> 6), lane = tid & 63, wr = wid >> 2, wc = wid & 3, fr = lane & 15, fq = lane >> 4;
    const int K = g.K, nt = K / BK;
    unsigned voffA[2], voffB[2];
#pragma unroll
    for (int i = 0; i < 2; ++i) { int R, C; stage_rc(tid * 16 + i * 8192, R, C); const int Rb = Epi::PERM ? ((R & ~31) + perm32(R & 31)) : R;
        voffA[i] = (unsigned)(R * K + C) * 2u; voffB[i] = (unsigned)(Rb * K + C) * 2u; }
    const size_t kstep = (size_t)(BK * 2);
    const size_t hstep = (size_t)HALF * K * 2;
    const size_t tstep = 2 * hstep;
    const unsigned ldsw = (unsigned)wid * 1024u;
    const int aoff = lds_byte(wr * 64 + fr, fq * 8), boff = lds_byte(wc * 32 + fr, fq * 8);
#define PG8_SA(b, h) (((b) * 2 + (h)) * HTB)
#define PG8_SB(b, h) ((4 + (b) * 2 + (h)) * HTB)
#define PG8_STAGE(bufoff, gbase, voff) do { _Pragma("unroll") for (int _i = 0; _i < 2; ++_i) \
        __builtin_amdgcn_global_load_lds((const unsigned*)((const char*)(gbase) + (voff)[_i]), (PG8_LAS unsigned*)(lds + (bufoff) + ldsw + _i * 8192), 16, 0, 0); } while (0)
#define PG8_LDA(dst, b, h) do { _Pragma("unroll") for (int m = 0; m < 4; ++m) _Pragma("unroll") for (int k = 0; k < 2; ++k) dst[m][k] = *(const PG8_LAS bf16x8*)(lds + PG8_SA(b, h) + aoff + m * 2048 + k * 1024); } while (0)
#define PG8_LDB(dst, b, h) do { _Pragma("unroll") for (int n = 0; n < 2; ++n) _Pragma("unroll") for (int k = 0; k < 2; ++k) dst[n][k] = *(const PG8_LAS bf16x8*)(lds + PG8_SB(b, h) + boff + n * 2048 + k * 1024); } while (0)
#define PG8_MMA(ai, bj, At, Bt) do { __builtin_amdgcn_s_setprio(1); _Pragma("unroll") for (int m = 0; m < 4; ++m) _Pragma("unroll") for (int n = 0; n < 2; ++n) _Pragma("unroll") for (int k = 0; k < 2; ++k) \
        acc[ai][bj][m][n] = __builtin_amdgcn_mfma_f32_16x16x32_bf16(Bt[n][k], At[m][k], acc[ai][bj][m][n], 0, 0, 0); __builtin_amdgcn_s_setprio(0); } while (0)
#define PG8_WAIT_V(n) asm volatile("s_waitcnt vmcnt(" #n ")" ::: "memory")
#define PG8_WAIT_L(n) asm volatile("s_waitcnt lgkmcnt(" #n ")" ::: "memory")
#define PG8_BAR __builtin_amdgcn_s_barrier()
#define PG8_SCHED __builtin_amdgcn_sched_barrier(0)
    Unit cur, nxt; int ui = 0;
    if (!S.next(0, cur)) return;
    f32x4 acc[2][2][4][2];
#pragma unroll
    for (int a = 0; a < 2; ++a)
#pragma unroll
        for (int b = 0; b < 2; ++b)
#pragma unroll
            for (int m = 0; m < 4; ++m)
#pragma unroll
                for (int n = 0; n < 2; ++n) acc[a][b][m][n] = (f32x4){0.f, 0.f, 0.f, 0.f};
    bf16x8 At[4][2], B0[2][2], B1[2][2];
    const char* cA = (const char*)g.A + (size_t)cur.pm * tstep; const char* cB = (const char*)g.Bt + (size_t)cur.pn * tstep;
    S.a_ready(cur);
    if constexpr (SP2) {
        PG8_STAGE(PG8_SB(0, 0), cB, voffB); PG8_STAGE(PG8_SB(0, 1), cB + hstep, voffB); PG8_STAGE(PG8_SA(0, 0), cA, voffA); PG8_STAGE(PG8_SA(0, 1), cA + hstep, voffA);
        if (wr == 1) PG8_BAR;
        PG8_WAIT_V(2); PG8_BAR;
        PG8_STAGE(PG8_SB(1, 0), cB + kstep, voffB); PG8_STAGE(PG8_SA(1, 0), cA + kstep, voffA); PG8_STAGE(PG8_SB(1, 1), cB + hstep + kstep, voffB);
        PG8_WAIT_V(6); PG8_BAR;
    } else {
        PG8_STAGE(PG8_SB(0, 0), cB, voffB); PG8_STAGE(PG8_SA(0, 0), cA, voffA); PG8_STAGE(PG8_SB(0, 1), cB + hstep, voffB); PG8_STAGE(PG8_SA(0, 1), cA + hstep, voffA);
        if (wr == 1) PG8_BAR;
        PG8_WAIT_V(4); PG8_BAR;
        PG8_STAGE(PG8_SB(1, 0), cB + kstep, voffB); PG8_STAGE(PG8_SA(1, 0), cA + kstep, voffA); PG8_STAGE(PG8_SB(1, 1), cB + hstep + kstep, voffB);
        PG8_WAIT_V(6); PG8_BAR;
    }
    for (;;) {
        const bool has_next = S.next(ui + 1, nxt);
        const char* nA = has_next ? (const char*)g.A + (size_t)nxt.pm * tstep : cA; const char* nB = has_next ? (const char*)g.Bt + (size_t)nxt.pn * tstep : cB;
        for (int t = 0; t < nt; t += 2) {
            const bool last = (t == nt - 2);
            const char* a1 = cA + (size_t)(t + 1) * kstep;
            const char* a2 = last ? nA : cA + (size_t)(t + 2) * kstep; const char* b2 = last ? nB : cB + (size_t)(t + 2) * kstep;
            const char* a3 = a2 + kstep; const char* b3 = b2 + kstep;
            if (last && has_next) S.a_ready(nxt);
            if constexpr (SP2) {
            PG8_LDB(B0, 0, 0); PG8_LDB(B1, 0, 1); PG8_SCHED; PG8_LDA(At, 0, 0); PG8_STAGE(PG8_SA(1, 1), a1 + hstep, voffA);
            PG8_WAIT_V(8); PG8_WAIT_L(0); PG8_BAR; PG8_MMA(0, 0, At, B0); PG8_MMA(0, 1, At, B1); PG8_BAR; PG8_SCHED;
            PG8_LDA(At, 0, 1); PG8_STAGE(PG8_SB(0, 0), b2, voffB); PG8_STAGE(PG8_SB(0, 1), b2 + hstep, voffB); PG8_STAGE(PG8_SA(0, 0), a2, voffA);
            PG8_WAIT_V(8); PG8_WAIT_L(0); PG8_BAR; PG8_MMA(1, 0, At, B0); PG8_MMA(1, 1, At, B1); PG8_BAR; PG8_SCHED;
            PG8_LDB(B0, 1, 0); PG8_LDB(B1, 1, 1); PG8_SCHED; PG8_LDA(At, 1, 0); PG8_STAGE(PG8_SA(0, 1), a2 + hstep, voffA);
            PG8_WAIT_V(8); PG8_WAIT_L(0); PG8_BAR; PG8_MMA(0, 0, At, B0); PG8_MMA(0, 1, At, B1); PG8_BAR; PG8_SCHED;
            PG8_LDA(At, 1, 1); PG8_STAGE(PG8_SB(1, 0), b3, voffB); PG8_STAGE(PG8_SB(1, 1), b3 + hstep, voffB); PG8_STAGE(PG8_SA(1, 0), a3, voffA);
            PG8_WAIT_V(8); PG8_WAIT_L(0); PG8_BAR; PG8_MMA(1, 0, At, B0); PG8_MMA(1, 1, At, B1); PG8_BAR; PG8_SCHED;
            } else {
            PG8_LDB(B0, 0, 0); PG8_SCHED; PG8_LDA(At, 0, 0); PG8_STAGE(PG8_SA(1, 1), a1 + hstep, voffA);
            PG8_WAIT_L(8); PG8_BAR; PG8_WAIT_L(0); PG8_MMA(0, 0, At, B0); PG8_BAR; PG8_SCHED;
            PG8_LDB(B1, 0, 1); PG8_STAGE(PG8_SB(0, 0), b2, voffB);
            PG8_BAR; PG8_WAIT_L(0); PG8_MMA(0, 1, At, B1); PG8_BAR;
            PG8_LDA(At, 0, 1); PG8_STAGE(PG8_SA(0, 0), a2, voffA);
            PG8_BAR; PG8_WAIT_L(0); PG8_MMA(1, 0, At, B0); PG8_BAR; PG8_SCHED;
            PG8_STAGE(PG8_SB(0, 1), b2 + hstep, voffB);
            PG8_WAIT_V(6); PG8_BAR; PG8_MMA(1, 1, At, B1); PG8_BAR;
            PG8_LDB(B0, 1, 0); PG8_SCHED; PG8_LDA(At, 1, 0); PG8_STAGE(PG8_SA(0, 1), a2 + hstep, voffA);
            PG8_WAIT_L(8); PG8_BAR; PG8_WAIT_L(0); PG8_MMA(0, 0, At, B0); PG8_BAR; PG8_SCHED;
            PG8_LDB(B1, 1, 1); PG8_STAGE(PG8_SB(1, 0), b3, voffB);
            PG8_BAR; PG8_WAIT_L(0); PG8_MMA(0, 1, At, B1); PG8_BAR;
            PG8_LDA(At, 1, 1); PG8_STAGE(PG8_SA(1, 0), a3, voffA);
            PG8_BAR; PG8_WAIT_L(0); PG8_MMA(1, 0, At, B0); PG8_BAR; PG8_SCHED;
            PG8_STAGE(PG8_SB(1, 1), b3 + hstep, voffB);
            PG8_WAIT_V(6); PG8_BAR; PG8_MMA(1, 1, At, B1); PG8_BAR;
            }
        }
        if constexpr (ALIGN_EPI) { if (wr == 0) PG8_BAR; }
        if constexpr (!Epi::AFTER_DRAIN) { E(acc, cur, wr, wc, fr, fq); S.done(cur); }
        if (!has_next) break;
#pragma unroll
        for (int a = 0; a < 2; ++a)
#pragma unroll
            for (int b = 0; b < 2; ++b)
#pragma unroll
                for (int m = 0; m < 4; ++m)
#pragma unroll
                    for (int n = 0; n < 2; ++n) acc[a][b][m][n] = (f32x4){0.f, 0.f, 0.f, 0.f};
        cur = nxt; cA = nA; cB = nB; ++ui;
        if constexpr (ALIGN_EPI) { if (wr == 1) PG8_BAR; }
    }
    PG8_WAIT_V(0);
    if constexpr (!ALIGN_EPI) { if (wr == 0) PG8_BAR; }
    PG8_BAR;
    if constexpr (Epi::AFTER_DRAIN) { E.fused(acc, cur, wr, wc, fr, fq, lds, wid, lane); S.done(cur); }
#undef PG8_SA
#undef PG8_SB
#undef PG8_STAGE
#undef PG8_LDA
#undef PG8_LDB
#undef PG8_MMA
#undef PG8_WAIT_V
#undef PG8_WAIT_L
#undef PG8_BAR
#undef PG8_SCHED
}
}
#define LAS __attribute__((address_space(3)))
typedef unsigned short bf16;
typedef float f32x4 __attribute__((ext_vector_type(4)));
typedef float f32x16 __attribute__((ext_vector_type(16)));
typedef unsigned u32x4 __attribute__((ext_vector_type(4)));
typedef unsigned u32x2 __attribute__((ext_vector_type(2)));
typedef short bf16x8 __attribute__((ext_vector_type(8)));

#ifndef FAST_SB
#define FAST_SB 0
#endif
#ifndef FAST_GLA
#define FAST_GLA 0
#endif

constexpr int NB = 16, S = 2048, D = 1024, M = NB * S, FF = 4096, NLAYER = 4;
constexpr int GLA_NA = 2304;
constexpr int PQ = 0, PK = 512, PG = 1024, PA1 = 2048;
constexpr float ALPHA = 1.681792830507429f, LN_EPS = 1e-5f, RMS_EPS = 1e-6f;
constexpr float C2_SB = 0.125f * 1.4426950408889634f;
constexpr size_t MiB = 1u << 20;
constexpr size_t WS_WA = 2 * MiB, WS_WV = 7 * MiB, WS_WO = 9 * MiB, WS_WUP = 12 * MiB, WS_WDN = 20 * MiB;
constexpr size_t WS_HB = 32 * MiB, WS_KB = 96 * MiB, WS_VT = 160 * MiB, WS_BIG = 224 * MiB, WS_END = 480 * MiB;
constexpr int LDS_BYTES = 155648;

struct Args { const float* in[13]; float* out; unsigned char* ws; };

__device__ __forceinline__ float bf2f(unsigned x) { return __uint_as_float(x << 16); }
__device__ __forceinline__ unsigned f2bf(float f) { unsigned u = __float_as_uint(f); return (u + 0x7fffu + ((u >> 16) & 1u)) >> 16; }
__device__ __forceinline__ unsigned pk2(float lo, float hi) { return f2bf(lo) | (f2bf(hi) << 16); }
__device__ __forceinline__ float wave_sum(float v) {
#pragma unroll
    for (int o = 1; o < 64; o <<= 1) v += __shfl_xor(v, o);
    return v;
}

namespace pg8 {
template <int ACT  > struct EpiB {
    static constexpr bool PERM = true, AFTER_DRAIN = false;
    bf16_t* O; int ldc; int split_cols; size_t split_stride; float scale0;
    __device__ __forceinline__ void operator()(const f32x4 (&acc)[2][2][4][2], const Unit& u, int wr, int wc, int fr, int fq) const {
        const int row0 = u.pm * BM + wr * 64 + fr; int colt = u.pn * BM; bf16_t* base = O;
        float sc = 1.f; if (split_cols) { const int t = colt / split_cols; base += (size_t)t * split_stride; colt -= t * split_cols; if (t == 0) sc = scale0; }
        const int col0 = colt + wc * 32 + 8 * fq;
#pragma unroll
        for (int ai = 0; ai < 2; ++ai)
#pragma unroll
            for (int m = 0; m < 4; ++m) { bf16_t* rowp = base + (size_t)(row0 + ai * HALF + m * 16) * ldc + col0;
#pragma unroll
                for (int bj = 0; bj < 2; ++bj) { f32x4 v0 = acc[ai][bj][m][0], v1 = acc[ai][bj][m][1];
                    if (ACT == 2) { v0 = __builtin_elementwise_max(v0, (f32x4){0.f, 0.f, 0.f, 0.f}); v1 = __builtin_elementwise_max(v1, (f32x4){0.f, 0.f, 0.f, 0.f}); v0 = v0 * v0; v1 = v1 * v1; }
                    v0 = v0 * sc; v1 = v1 * sc; u32x4 w; w.x = cvt_pk_bf16(v0[0], v0[1]); w.y = cvt_pk_bf16(v0[2], v0[3]); w.z = cvt_pk_bf16(v1[0], v1[1]); w.w = cvt_pk_bf16(v1[2], v1[3]);
                    *(u32x4*)(rowp + bj * HALF) = w; } }
    }
};
struct EpiRes {
    static constexpr bool PERM = false, AFTER_DRAIN = false;
    float* io; int ldc; float alpha;
    __device__ __forceinline__ void operator()(const f32x4 (&acc)[2][2][4][2], const Unit& u, int wr, int wc, int fr, int fq) const {
        const int col0 = u.pn * BM + wc * 32 + 4 * fq;
#pragma unroll
        for (int ai = 0; ai < 2; ++ai)
#pragma unroll
            for (int m = 0; m < 4; ++m) { float* rowp = io + (size_t)(u.pm * BM + ai * HALF + wr * 64 + m * 16 + fr) * ldc + col0;
#pragma unroll
                for (int bj = 0; bj < 2; ++bj)
#pragma unroll
                    for (int n = 0; n < 2; ++n) { f32x4* p = (f32x4*)(rowp + bj * HALF + n * 16); const f32x4 b = *p; *p = b * alpha + acc[ai][bj][m][n]; }
                asm volatile("" ::: "memory"); }
    }
};
}

__device__ __forceinline__ void transpose_item(const float* W, int ldw, int K, bf16* WT, LAS float* scr, int kb, int nb, int lane) {
    const int k0 = 64 * kb, n0 = 32 * nb;
#pragma unroll 8
    for (int i = 0; i < 32; ++i) { const int kk = 2 * i + (lane >> 5); scr[kk * 33 + (lane & 31)] = W[(size_t)(k0 + kk) * ldw + n0 + (lane & 31)]; }
    asm volatile("s_waitcnt lgkmcnt(0)" ::: "memory");
    const int c = lane & 7;
#pragma unroll
    for (int j = 0; j < 4; ++j) { const int n = (lane >> 3) + 8 * j; const LAS float* s = scr + (8 * c) * 33 + n;
        u32x4 o; o.x = pk2(s[0 * 33], s[1 * 33]); o.y = pk2(s[2 * 33], s[3 * 33]); o.z = pk2(s[4 * 33], s[5 * 33]); o.w = pk2(s[6 * 33], s[7 * 33]);
        *(u32x4*)(WT + (size_t)(n0 + n) * K + k0 + 8 * c) = o; }
    asm volatile("s_waitcnt lgkmcnt(0)" ::: "memory");
}
__device__ __forceinline__ void convert_job(const float* W, int ldw, int K, int ncols, bf16* WT, LAS float* scr, int gw, int NGW, int lane) {
    const int nblk = ncols / 32, nitems = (K / 64) * nblk;
    for (int it = gw; it < nitems; it += NGW) transpose_item(W, ldw, K, WT, scr, it / nblk, it % nblk, lane);
}
__device__ __forceinline__ void convert_layer(const Args& a, int L, LAS unsigned char* lds, int wave, int lane, int gw, int NGW) {
    LAS float* scr = (LAS float*)(lds + wave * 16384);
    unsigned char* ws = a.ws;
    bf16* WA = (bf16*)(ws + WS_WA); bf16* WV = (bf16*)(ws + WS_WV); bf16* WO = (bf16*)(ws + WS_WO); bf16* WUP = (bf16*)(ws + WS_WUP); bf16* WDN = (bf16*)(ws + WS_WDN);
    if (L < 2) {
        const float* win = a.in[1] + (size_t)L * D * 3088;
        convert_job(win + 0, 3088, D, 512, WA + (size_t)PQ * D, scr, gw, NGW, lane);
        convert_job(win + 512, 3088, D, 512, WA + (size_t)PK * D, scr, gw, NGW, lane);
        convert_job(win + 2048, 3088, D, 1024, WA + (size_t)PG * D, scr, gw, NGW, lane);
        convert_job(win + 1024, 3088, D, 1024, WV, scr, gw, NGW, lane);
        convert_job(a.in[5] + (size_t)L * D * D, D, D, D, WO, scr, gw, NGW, lane);
        const int gt = gw * 64 + lane, NT = NGW * 64;
        for (int idx = gt; idx < 16 * D; idx += NT) { const int n = idx / D, k = idx % D; WA[(size_t)(PA1 + n) * D + k] = (bf16)f2bf(win[(size_t)k * 3088 + 3072 + n]); }
        for (int idx = gt; idx < 240 * D / 8; idx += NT) ((u32x4*)(WA + (size_t)(PA1 + 16) * D))[idx] = (u32x4){0u, 0u, 0u, 0u};
    } else {
        const int j = L - 2;
        convert_job(a.in[7] + (size_t)j * D * D, D, D, D, WA, scr, gw, NGW, lane);
        if (j == 0) {
            convert_job(a.in[6] + 0, 2 * D, D, D, WA + (size_t)D * D, scr, gw, NGW, lane);
            convert_job(a.in[6] + D, 2 * D, D, D, WV, scr, gw, NGW, lane);
        }
        convert_job(a.in[8] + (size_t)j * D * D, D, D, D, WO, scr, gw, NGW, lane);
    }
    convert_job(a.in[9] + (size_t)L * D * FF, FF, D, FF, WUP, scr, gw, NGW, lane);
    convert_job(a.in[10] + (size_t)L * FF * D, D, FF, D, WDN, scr, gw, NGW, lane);
}

__device__ __forceinline__ void ln_phase(float* hf, bf16* hb, const float* g, const float* b, int gw, int NGW, int lane) {
    f32x4 gv[4], bv[4];
#pragma unroll
    for (int j = 0; j < 4; ++j) { gv[j] = ((const f32x4*)g)[lane + 64 * j]; bv[j] = ((const f32x4*)b)[lane + 64 * j]; }
    for (int m = gw; m < M; m += NGW) {
        f32x4* xr = (f32x4*)(hf + (size_t)m * D) + lane;
        f32x4 v[4]; float s = 0.f;
#pragma unroll
        for (int j = 0; j < 4; ++j) { v[j] = xr[64 * j]; s += (v[j].x + v[j].y) + (v[j].z + v[j].w); }
        const float mean = wave_sum(s) * (1.f / D); float s2 = 0.f;
#pragma unroll
        for (int j = 0; j < 4; ++j) { v[j] = v[j] - mean; s2 += (v[j].x * v[j].x + v[j].y * v[j].y) + (v[j].z * v[j].z + v[j].w * v[j].w); }
        const float rstd = 1.f / sqrtf(wave_sum(s2) * (1.f / D) + LN_EPS);
        u32x2* o8 = (u32x2*)(hb + (size_t)m * D) + lane;
#pragma unroll
        for (int j = 0; j < 4; ++j) { const f32x4 y = v[j] * rstd * gv[j] + bv[j]; xr[64 * j] = y; o8[64 * j] = (u32x2){pk2(y.x, y.y), pk2(y.z, y.w)}; }
    }
}
__device__ __forceinline__ float log_sigmoid_f(float z) { return fminf(z, 0.f) - log1pf(expf(-fabsf(z))); }

__device__ __forceinline__ void sb_naive(const bf16* Q, const bf16* K, const bf16* VT, bf16* O, int gtid, int nthreads) {
    int it = 0;
#pragma unroll 1
    for (int base = 0; base < NB * 16 * S; base += nthreads, ++it) {
        const int task = base + gtid;
        const int bh = __builtin_amdgcn_readfirstlane(task / S), tt = task % S;
        const int t = (it & 1) ? (S - 1 - tt) : tt;
        const int b = bh >> 4, h = bh & 15;
        const int tt0 = __builtin_amdgcn_readfirstlane(tt & ~63);
        const int tmax = (it & 1) ? (S - 1 - tt0) : (tt0 | 63);
        float q[64], o[64];
        { const u32x4* qp = (const u32x4*)(Q + (size_t)(b * S + t) * D + h * 64);
#pragma unroll
          for (int i = 0; i < 8; ++i) { const u32x4 w = qp[i];
              q[8 * i + 0] = bf2f(w.x & 0xffffu); q[8 * i + 1] = bf2f(w.x >> 16); q[8 * i + 2] = bf2f(w.y & 0xffffu); q[8 * i + 3] = bf2f(w.y >> 16);
              q[8 * i + 4] = bf2f(w.z & 0xffffu); q[8 * i + 5] = bf2f(w.z >> 16); q[8 * i + 6] = bf2f(w.w & 0xffffu); q[8 * i + 7] = bf2f(w.w >> 16); } }
#pragma unroll
        for (int d = 0; d < 64; ++d) o[d] = 0.f;
        float P = 1.f;
#pragma unroll 1
        for (int s = tmax - 1; s >= 0; --s) {
            const u32x4* kp = (const u32x4*)(K + (size_t)(b * S + s) * D + h * 64);
            float z = 0.f;
#pragma unroll
            for (int i = 0; i < 8; ++i) { const u32x4 kw = kp[i];
                z += q[8 * i + 0] * bf2f(kw.x & 0xffffu); z += q[8 * i + 1] * bf2f(kw.x >> 16); z += q[8 * i + 2] * bf2f(kw.y & 0xffffu); z += q[8 * i + 3] * bf2f(kw.y >> 16);
                z += q[8 * i + 4] * bf2f(kw.z & 0xffffu); z += q[8 * i + 5] * bf2f(kw.z >> 16); z += q[8 * i + 6] * bf2f(kw.w & 0xffffu); z += q[8 * i + 7] * bf2f(kw.w >> 16); }
            const float e = (s < t) ? exp2f(fminf(z, 100.f)) : 0.f;
            const float r = 1.f / (1.f + e);
            P *= r; const float w = e * P;
            const bf16* vp = VT + (size_t)(h * 64) * M + b * S + s;
#pragma unroll
            for (int d = 0; d < 64; ++d) { o[d] += w * bf2f(vp[(size_t)d * M]); if ((d & 7) == 7) asm volatile("" ::: "memory"); }
        }
        u32x4* op = (u32x4*)(O + (size_t)(b * S + t) * D + h * 64);
#pragma unroll
        for (int i = 0; i < 8; ++i) op[i] = (u32x4){pk2(o[8 * i], o[8 * i + 1]), pk2(o[8 * i + 2], o[8 * i + 3]), pk2(o[8 * i + 4], o[8 * i + 5]), pk2(o[8 * i + 6], o[8 * i + 7])};
    }
}

__device__ __forceinline__ void gla_gate_naive(const bf16* PROJ, const float* wa2, const float* ba, float* A, int gtid, int nthreads) {
    for (int idx = gtid; idx < M * 512; idx += nthreads) {
        const int t = idx >> 9, c = idx & 511;
        float z = ba[c];
        const u32x4* ap = (const u32x4*)(PROJ + (size_t)t * GLA_NA + PA1);
        const u32x4 a0 = ap[0], a1 = ap[1];
        const unsigned aw[8] = {a0.x, a0.y, a0.z, a0.w, a1.x, a1.y, a1.z, a1.w};
#pragma unroll
        for (int r = 0; r < 8; ++r) { z += bf2f(aw[r] & 0xffffu) * wa2[(2 * r) * 512 + c]; z += bf2f(aw[r] >> 16) * wa2[(2 * r + 1) * 512 + c]; }
        A[idx] = expf(log_sigmoid_f(z) * (1.f / 16.f));
    }
}
__device__ __forceinline__ void gla_rec_naive(const bf16* PROJ, const float* A, const bf16* VT, float* OU, int gtid) {
    if (gtid >= NB * 4 * 256) return;
    const int bh = __builtin_amdgcn_readfirstlane(gtid >> 8), e = gtid & 255, b = bh >> 2, h = bh & 3;
    float st[128];
#pragma unroll
    for (int c = 0; c < 128; ++c) st[c] = 0.f;
    const bf16* vt = VT + (size_t)(h * 256 + e) * M + b * S;
    for (int t = 0; t < S; ++t) {
        const size_t row = (size_t)b * S + t;
        const u32x4* qp = (const u32x4*)(PROJ + row * GLA_NA + PQ + h * 128);
        const u32x4* kp = (const u32x4*)(PROJ + row * GLA_NA + PK + h * 128);
        const f32x4* ap = (const f32x4*)(A + row * 512 + h * 128);
        const float v = bf2f(vt[t]);
        float o = 0.f;
#pragma unroll
        for (int i = 0; i < 16; ++i) {
            const u32x4 qw = qp[i], kw = kp[i]; const f32x4 a0 = ap[2 * i], a1 = ap[2 * i + 1];
            const unsigned qa[4] = {qw.x, qw.y, qw.z, qw.w}, ka[4] = {kw.x, kw.y, kw.z, kw.w};
            const float aa[8] = {a0.x, a0.y, a0.z, a0.w, a1.x, a1.y, a1.z, a1.w};
#pragma unroll
            for (int j = 0; j < 4; ++j) {
                const int c = 8 * i + 2 * j;
                st[c] = aa[2 * j] * st[c] + bf2f(ka[j] & 0xffffu) * v;         o += bf2f(qa[j] & 0xffffu) * st[c];
                st[c + 1] = aa[2 * j + 1] * st[c + 1] + bf2f(ka[j] >> 16) * v; o += bf2f(qa[j] >> 16) * st[c + 1];
            }
        }
        OU[row * D + h * 256 + e] = o * 0.08838834764831845f;
    }
}
__device__ __forceinline__ void gla_norm_naive(const float* OU, const bf16* PROJ, const float* ng, bf16* O, int gw, int NGW, int lane) {
    const f32x4 g4 = ((const f32x4*)ng)[lane];
    for (int task = gw; task < M * 4; task += NGW) {
        const int t = task >> 2, h = task & 3;
        const f32x4 v = *(const f32x4*)(OU + (size_t)t * D + h * 256 + 4 * lane);
        const float ss = wave_sum((v.x * v.x + v.y * v.y) + (v.z * v.z + v.w * v.w));
        const float rstd = 1.f / sqrtf(ss * (1.f / 256.f) + RMS_EPS);
        const u32x2 gw2 = *(const u32x2*)(PROJ + (size_t)t * GLA_NA + PG + h * 256 + 4 * lane);
        const float gg[4] = {bf2f(gw2.x & 0xffffu), bf2f(gw2.x >> 16), bf2f(gw2.y & 0xffffu), bf2f(gw2.y >> 16)};
        float y[4];
#pragma unroll
        for (int i = 0; i < 4; ++i) y[i] = v[i] * rstd * g4[i] * (gg[i] / (1.f + expf(-gg[i])));
        *(u32x2*)(O + (size_t)t * D + h * 256 + 4 * lane) = (u32x2){pk2(y[0], y[1]), pk2(y[2], y[3])};
    }
}
template <int L> __device__ __forceinline__ void run_layer(const Args& a, cg::grid_group& grid, LAS unsigned char* lds) {
    const int tid = threadIdx.x, lane = tid & 63, wave = __builtin_amdgcn_readfirstlane(tid >> 6);
    const int G = gridDim.x, gw = blockIdx.x * 8 + wave, NGW = G * 8, gtid = blockIdx.x * 512 + tid, NTH = G * 512;
    unsigned char* ws = a.ws;
    bf16* WA = (bf16*)(ws + WS_WA); bf16* WV = (bf16*)(ws + WS_WV); bf16* WO = (bf16*)(ws + WS_WO); bf16* WUP = (bf16*)(ws + WS_WUP); bf16* WDN = (bf16*)(ws + WS_WDN);
    bf16* HB = (bf16*)(ws + WS_HB); bf16* KB = (bf16*)(ws + WS_KB); bf16* VT = (bf16*)(ws + WS_VT); bf16* BIG = (bf16*)(ws + WS_BIG);
    float* HF = a.out;
    (void)gtid; (void)NTH; (void)WV; (void)KB;
        bf16* OB;
        if constexpr (L < 2) {
            bf16* PROJ = BIG;
            { pg8::Gemm g{HB, WA, M, GLA_NA, D}; pg8::StaticOrder So; So.init(M, GLA_NA, G, (int)blockIdx.x);
              pg8::EpiB<0> E{PROJ, GLA_NA, 0, 0, 1.f};
              pg8::gemm_phase<pg8::EpiB<0>, pg8::StaticOrder, true, true>(lds, g, So, E); }
            { pg8::Gemm g{WV, HB, D, M, D}; pg8::StaticOrder So; So.init(D, M, G, (int)blockIdx.x);
              pg8::EpiB<0> E{VT, M, 0, 0, 1.f};
              pg8::gemm_phase<pg8::EpiB<0>, pg8::StaticOrder, true, true>(lds, g, So, E); }
            grid.sync();
            const float* wa2 = a.in[2] + (size_t)L * 16 * 512; const float* ba = a.in[3] + (size_t)L * 512; const float* ng = a.in[4] + (size_t)L * 256;
#if FAST_GLA
            OB = KB;
#else
            float* AG = (float*)(ws + WS_BIG + 144 * MiB); float* OU = (float*)(ws + WS_HB); OB = VT;
            gla_gate_naive(PROJ, wa2, ba, AG, gtid, NTH);
            grid.sync();
            gla_rec_naive(PROJ, AG, VT, OU, gtid);
            grid.sync();
            gla_norm_naive(OU, PROJ, ng, OB, gw, NGW, lane);
#endif
            grid.sync();
        } else {
            constexpr int j = L - 2;
            bf16* QB = BIG; OB = BIG + (size_t)M * D;
            { const int N = (j == 0) ? 2 * D : D;
              pg8::Gemm g{HB, WA, M, N, D}; pg8::StaticOrder So; So.init(M, N, G, (int)blockIdx.x);
              pg8::EpiB<0> E{QB, D, D, (size_t)(KB - QB), C2_SB};
              pg8::gemm_phase<pg8::EpiB<0>, pg8::StaticOrder, true, true>(lds, g, So, E); }
            if constexpr (j == 0) { pg8::Gemm g{WV, HB, D, M, D}; pg8::StaticOrder So; So.init(D, M, G, (int)blockIdx.x);
              pg8::EpiB<0> E{VT, M, 0, 0, 1.f};
              pg8::gemm_phase<pg8::EpiB<0>, pg8::StaticOrder, true, true>(lds, g, So, E); }
            grid.sync();
#if FAST_SB
#else
            sb_naive(QB, KB, VT, OB, gtid, NTH);
#endif
            grid.sync();
        }
        { pg8::Gemm g{OB, WO, M, D, D}; pg8::StaticOrder So; So.init(M, D, G, (int)blockIdx.x);
          pg8::EpiRes E{HF, D, ALPHA};
          pg8::gemm_phase<pg8::EpiRes, pg8::StaticOrder, true, true>(lds, g, So, E); }
        grid.sync();
        ln_phase(HF, HB, a.in[11] + (size_t)(L * 2 + 0) * D, a.in[12] + (size_t)(L * 2 + 0) * D, gw, NGW, lane);
        grid.sync();
        { pg8::Gemm g{HB, WUP, M, FF, D}; pg8::StaticOrder So; So.init(M, FF, G, (int)blockIdx.x);
          pg8::EpiB<2> E{BIG, FF, 0, 0, 1.f};
          pg8::gemm_phase<pg8::EpiB<2>, pg8::StaticOrder, true, true>(lds, g, So, E); }
        grid.sync();
        { pg8::Gemm g{BIG, WDN, M, D, FF}; pg8::StaticOrder So; So.init(M, D, G, (int)blockIdx.x);
          pg8::EpiRes E{HF, D, ALPHA};
          pg8::gemm_phase<pg8::EpiRes, pg8::StaticOrder, true, true>(lds, g, So, E); }
        grid.sync();
        ln_phase(HF, HB, a.in[11] + (size_t)(L * 2 + 1) * D, a.in[12] + (size_t)(L * 2 + 1) * D, gw, NGW, lane);
        if constexpr (L + 1 < NLAYER) { convert_layer(a, L + 1, lds, wave, lane, gw, NGW); grid.sync(); }
}

__global__ void __launch_bounds__(512, 2) yoco_fwd(Args a) {
    extern __shared__ __attribute__((aligned(16))) unsigned char lds_raw[];
    cg::grid_group grid = cg::this_grid();
    LAS unsigned char* lds = (LAS unsigned char*)lds_raw;
    const int tid = threadIdx.x, lane = tid & 63, wave = __builtin_amdgcn_readfirstlane(tid >> 6);
    const int G = gridDim.x, gw = blockIdx.x * 8 + wave, NGW = G * 8, gtid = blockIdx.x * 512 + tid, NTH = G * 512;
    unsigned char* ws = a.ws;
    bf16* WA = (bf16*)(ws + WS_WA); bf16* WV = (bf16*)(ws + WS_WV); bf16* WO = (bf16*)(ws + WS_WO); bf16* WUP = (bf16*)(ws + WS_WUP); bf16* WDN = (bf16*)(ws + WS_WDN);
    bf16* HB = (bf16*)(ws + WS_HB); bf16* KB = (bf16*)(ws + WS_KB); bf16* VT = (bf16*)(ws + WS_VT); bf16* BIG = (bf16*)(ws + WS_BIG);
    float* HF = a.out;

    convert_layer(a, 0, lds, wave, lane, gw, NGW);
    { const f32x4* xs = (const f32x4*)a.in[0]; f32x4* hd = (f32x4*)HF; u32x2* hb = (u32x2*)HB;
      for (int i = gtid; i < M * D / 4; i += NTH) { const f32x4 v = xs[i]; hd[i] = v; hb[i] = (u32x2){pk2(v.x, v.y), pk2(v.z, v.w)}; } }
    grid.sync();

    run_layer<0>(a, grid, lds);
    run_layer<1>(a, grid, lds);
    run_layer<2>(a, grid, lds);
    run_layer<3>(a, grid, lds);
}

extern "C" void kernel_launch(void* const* d_in, const int* in_sizes, int n_in, void* d_out, int out_size, void* d_ws, size_t ws_size, hipStream_t stream) {
    static int grid = 0;
    if (grid == 0) {
        if (n_in != 13 || out_size != M * D || ws_size < WS_END) { fprintf(stderr, "kernel_launch: unexpected shapes (n_in %d out %d ws %zu)\n", n_in, out_size, ws_size); grid = -1; return; }
        int dev = 0, cus = 0, per_cu = 0;
        hipGetDevice(&dev); hipDeviceGetAttribute(&cus, hipDeviceAttributeMultiprocessorCount, dev);
        hipFuncSetAttribute((const void*)yoco_fwd, hipFuncAttributeMaxDynamicSharedMemorySize, LDS_BYTES);
        hipOccupancyMaxActiveBlocksPerMultiprocessor(&per_cu, (const void*)yoco_fwd, 512, LDS_BYTES);
        if (per_cu < 1) { fprintf(stderr, "kernel_launch: occupancy query says %d blocks/CU\n", per_cu); per_cu = 1; }
        (void)hipGetLastError();
        grid = cus * 1;
    }
    if (grid < 0) return;
    Args a{};
    for (int i = 0; i < 13; ++i) a.in[i] = (const float*)d_in[i];
    a.out = (float*)d_out; a.ws = (unsigned char*)d_ws;
    void* args[] = {&a};
    hipError_t e = hipLaunchCooperativeKernel((const void*)yoco_fwd, dim3(grid), dim3(512), args, LDS_BYTES, stream);
    if (e != hipSuccess) fprintf(stderr, "cooperative launch failed: %s (grid %d)\n", hipGetErrorString(e), grid);
}
```

```cpp
#include <hip/hip_runtime.h>
#include <hip/hip_cooperative_groups.h>
#include <cstdio>
#include <cstdint>
namespace cg = cooperative_groups;
namespace pg8 {
#define PG8_LAS __attribute__((address_space(3)))
typedef unsigned short bf16_t;
typedef short bf16x8 __attribute__((ext_vector_type(8)));
typedef float f32x4 __attribute__((ext_vector_type(4)));
typedef unsigned u32x4 __attribute__((ext_vector_type(4)));
constexpr int BM = 256, BK = 64, HALF = 128, HTB = HALF * BK * 2  , STAGE_BYTES = 8 * HTB, NXCD = 8, WGM = 8;

__host__ __device__ __forceinline__ int lds_byte(int r, int c) { const int st = (r >> 4) * 2 + (c >> 5), rr = r & 15, cc = c & 31, ob = rr * 64 + cc * 2; return st * 1024 + (ob ^ (((ob >> 9) & 1) << 5)); }
__host__ __device__ __forceinline__ void stage_rc(int b, int& R, int& C) { const int st = b / 1024, sb = b % 1024, swz = sb ^ (((sb >> 9) & 1) << 5); R = (st >> 1) * 16 + swz / 64; C = (st & 1) * 32 + (swz % 64) / 2; }
__host__ __device__ __forceinline__ int perm32(int rho) { const int n = rho >> 4, i = rho & 15; return 8 * (i >> 2) + 4 * n + (i & 3); }

struct Unit { int pm, pn; };
struct Gemm { const bf16_t* A; const bf16_t* Bt; int M, N, K; };

struct StaticOrder {
    int nM, nN, nwg, G, c;
    __host__ __device__ void init(int M, int N, int G_, int c_) { nM = M / BM; nN = N / BM; nwg = nM * nN; G = G_; c = c_; }
    __host__ __device__ bool next(int i, Unit& u) const {
        const long L = (long)i * G + c; if (L >= nwg) return false;
        int wgid = (int)L; { const int q = nwg / NXCD, r = nwg % NXCD, xcd = wgid % NXCD, off = wgid / NXCD; wgid = (xcd < r ? xcd * (q + 1) : r * (q + 1) + (xcd - r) * q) + off; }
        const int nig = WGM * nN, gid = wgid / nig, fm = gid * WGM, gsz = (nM - fm) < WGM ? (nM - fm) : WGM;
        u.pm = fm + ((wgid % nig) % gsz); u.pn = (wgid % nig) / gsz; return true;
    }
    __device__ __forceinline__ void a_ready(const Unit&) const {}
    __device__ __forceinline__ void done(const Unit&) const {}
};

__device__ __forceinline__ unsigned cvt_pk_bf16(float lo, float hi) { unsigned r; asm volatile("v_cvt_pk_bf16_f32 %0, %1, %2" : "=v"(r) : "v"(lo), "v"(hi)); return r; }
typedef float f32x2 __attribute__((ext_vector_type(2)));
__device__ __forceinline__ f32x2 gelu_pk(f32x2 v) {
    const f32x2 av = __builtin_elementwise_abs(v), d = av * 0.2316418882f + 1.0f;
    f32x2 t; t.x = __builtin_amdgcn_rcpf(d.x); t.y = __builtin_amdgcn_rcpf(d.y);
    f32x2 q = t * 0.5307027145f + (-0.7265760135f); q = q * t + 0.7107068705f; q = q * t + (-0.142248368f); q = q * t + 0.127414796f; q = q * t;
    const f32x2 s = (v * v) * (-0.72134752044f);
    f32x2 e; e.x = __builtin_amdgcn_exp2f(s.x); e.y = __builtin_amdgcn_exp2f(s.y);
    const f32x2 m = v * (q * e), r = v - m;
    f32x2 o; o.x = v.x < 0.f ? m.x : r.x; o.y = v.y < 0.f ? m.y : r.y; return o;
}

template <int ACT  > struct EpiBf16 {
    static constexpr bool PERM = true, AFTER_DRAIN = false; static_assert(ACT == 0 || ACT == 1, "EpiBf16: ACT is 0 (none) or 1 (gelu_pk)");
    bf16_t* O; int ldc; const float* bias; int split_cols; size_t split_stride; float scale0;
    __device__ __forceinline__ void operator()(const f32x4 (&acc)[2][2][4][2], const Unit& u, int wr, int wc, int fr, int fq) const {
        const int row0 = u.pm * BM + wr * 64 + fr; int colt = u.pn * BM; bf16_t* base = O;
        float sc = 1.f; if (split_cols) { const int t = colt / split_cols; base += (size_t)t * split_stride; colt -= t * split_cols; if (t == 0) sc = scale0; }
        const int col0 = colt + wc * 32 + 8 * fq, bcol0 = u.pn * BM + wc * 32 + 8 * fq;
        f32x4 bv[2][2];
#pragma unroll
        for (int bj = 0; bj < 2; ++bj)
#pragma unroll
            for (int n = 0; n < 2; ++n) bv[bj][n] = bias ? *(const f32x4*)(bias + bcol0 + bj * HALF + 4 * n) : (f32x4){0.f, 0.f, 0.f, 0.f};
#pragma unroll
        for (int ai = 0; ai < 2; ++ai)
#pragma unroll
            for (int m = 0; m < 4; ++m) { bf16_t* rowp = base + (size_t)(row0 + ai * HALF + m * 16) * ldc + col0;
#pragma unroll
                for (int bj = 0; bj < 2; ++bj) { f32x4 v0 = acc[ai][bj][m][0] + bv[bj][0], v1 = acc[ai][bj][m][1] + bv[bj][1];
                    if (ACT == 1) { f32x2 a = gelu_pk((f32x2){v0[0], v0[1]}), b = gelu_pk((f32x2){v0[2], v0[3]}), c = gelu_pk((f32x2){v1[0], v1[1]}), d = gelu_pk((f32x2){v1[2], v1[3]});
                        v0 = (f32x4){a.x, a.y, b.x, b.y}; v1 = (f32x4){c.x, c.y, d.x, d.y}; }
                    v0 = v0 * sc; v1 = v1 * sc; u32x4 w; w.x = cvt_pk_bf16(v0[0], v0[1]); w.y = cvt_pk_bf16(v0[2], v0[3]); w.z = cvt_pk_bf16(v1[0], v1[1]); w.w = cvt_pk_bf16(v1[2], v1[3]);
                    *(u32x4*)(rowp + bj * HALF) = w; } }
    }
};

struct PanelStats {
    unsigned* xbuf;
    unsigned* cnt;
    unsigned* tmo;
    int ntn; float eps;
    unsigned code;
    __device__ __forceinline__ bool run(const f32x4 (&v)[2][2][4][2], const Unit& u, int wr, int wc, int fr, int fq, PG8_LAS unsigned char* lds, int wid, int lane) const {
        typedef float f32x2v __attribute__((ext_vector_type(2)));
        PG8_LAS f32x2v* P = (PG8_LAS f32x2v*)lds;
        PG8_LAS f32x2v* S = (PG8_LAS f32x2v*)(lds + 8192);
        PG8_LAS unsigned* flag = (PG8_LAS unsigned*)(lds + 8192 + 2048);
#pragma unroll
        for (int ai = 0; ai < 2; ++ai)
#pragma unroll
            for (int m = 0; m < 4; ++m) {
                float s = 0.f;
#pragma unroll
                for (int bj = 0; bj < 2; ++bj)
#pragma unroll
                    for (int n = 0; n < 2; ++n) { const f32x4 x = v[ai][bj][m][n]; s += (x[0] + x[1]) + (x[2] + x[3]); }
                s += __shfl_xor(s, 16); s += __shfl_xor(s, 32);
                const float mw = s * (1.0f / 64.0f); float q = 0.f;
#pragma unroll
                for (int bj = 0; bj < 2; ++bj)
#pragma unroll
                    for (int n = 0; n < 2; ++n) { const f32x4 d = v[ai][bj][m][n] - mw; q += (d[0] * d[0] + d[1] * d[1]) + (d[2] * d[2] + d[3] * d[3]); }
                q += __shfl_xor(q, 16); q += __shfl_xor(q, 32);
                if (fq == 0) P[(ai * HALF + wr * 64 + m * 16 + fr) * 4 + wc] = (f32x2v){mw, q};
            }
        asm volatile("s_waitcnt lgkmcnt(0)" ::: "memory"); __builtin_amdgcn_s_barrier(); asm volatile("" ::: "memory");
#if defined(BROKEN_EXCHANGE_NO_WAIT)
#warning BROKEN CONTROL BUILD: the row-statistics exchange does not wait; results are wrong by design
        if (blockIdx.x >= 64) { const long long t0_ = clock64(); while (clock64() - t0_ < 60000) __builtin_amdgcn_s_sleep(8); }
#endif
        const int row = wid * 32 + (lane & 31);
        if (lane < 32) {
            const f32x2v a = P[row * 4 + 0], b = P[row * 4 + 1], c = P[row * 4 + 2], d = P[row * 4 + 3];
            const float mt = (a.x + b.x + c.x + d.x) * 0.25f;
            const float da = a.x - mt, db = b.x - mt, dc = c.x - mt, dd = d.x - mt;
            const float m2 = (a.y + b.y) + (c.y + d.y) + 64.0f * ((da * da + db * db) + (dc * dc + dd * dd));
            unsigned long long* slot = (unsigned long long*)xbuf + ((size_t)(u.pm * BM + row) * 4 + u.pn);
            __hip_atomic_store(slot, ((unsigned long long)__float_as_uint(m2) << 32) | __float_as_uint(mt), __ATOMIC_RELAXED, __HIP_MEMORY_SCOPE_AGENT);
        }
        asm volatile("s_waitcnt vmcnt(0)" ::: "memory");
        if (lane == 0) __hip_atomic_fetch_add(cnt + 64 * u.pm, 1u, __ATOMIC_RELAXED, __HIP_MEMORY_SCOPE_AGENT);
        if (wid == 0) {
            bool dead = false; const unsigned long long t0 = __builtin_amdgcn_s_memrealtime(); const unsigned want = 8u * (unsigned)ntn;
            for (;;) {
#if defined(BROKEN_EXCHANGE_NO_WAIT)
                break;
#endif
                if ((unsigned)__builtin_amdgcn_readfirstlane(__hip_atomic_load(cnt + 64 * u.pm, __ATOMIC_RELAXED, __HIP_MEMORY_SCOPE_AGENT)) >= want) break;
                if (__builtin_amdgcn_s_memrealtime() - t0 > 2000000ull) {
                    if (lane == 0) { unsigned expect = 0u; __hip_atomic_compare_exchange_strong(tmo + 1, &expect, code | (unsigned)(u.pm & 0xff), __ATOMIC_RELAXED, __ATOMIC_RELAXED, __HIP_MEMORY_SCOPE_AGENT);
                                     __hip_atomic_store(tmo, 1u, __ATOMIC_RELAXED, __HIP_MEMORY_SCOPE_AGENT); }
                    dead = true; break; }
                __builtin_amdgcn_s_sleep(2);
            }
            __builtin_amdgcn_fence(__ATOMIC_ACQUIRE, "agent");
            if (lane == 0) flag[0] = dead ? 1u : 0u;
        }
        asm volatile("s_waitcnt vmcnt(0) lgkmcnt(0)" ::: "memory"); __builtin_amdgcn_s_barrier(); asm volatile("" ::: "memory");
        const bool bad = flag[0] != 0u;
        if (lane < 32) {
            const unsigned long long* slot = (const unsigned long long*)xbuf + (size_t)(u.pm * BM + row) * 4; float mt[4], m2[4]; float ms = 0.f;
#pragma unroll
            for (int t = 0; t < 4; ++t) { if (t < ntn) { const unsigned long long w = __hip_atomic_load(slot + t, __ATOMIC_RELAXED, __HIP_MEMORY_SCOPE_AGENT); mt[t] = __uint_as_float((unsigned)w); m2[t] = __uint_as_float((unsigned)(w >> 32)); } else { mt[t] = 0.f; m2[t] = 0.f; } ms += mt[t]; }
            const float mean = ms / (float)ntn; float q = 0.f;
#pragma unroll
            for (int t = 0; t < 4; ++t) if (t < ntn) { const float dm = mt[t] - mean; q += m2[t] + 256.0f * dm * dm; }
            S[row] = (f32x2v){mean, 1.0f / sqrtf(q / (256.0f * (float)ntn) + eps)};
        }
        asm volatile("s_waitcnt lgkmcnt(0)" ::: "memory"); __builtin_amdgcn_s_barrier(); asm volatile("" ::: "memory");
        return bad;
    }
};
struct EpiLnRes {
    static constexpr bool PERM = false, AFTER_DRAIN = true;
    const float* base; float* out; int ldc; const float* bias; PanelStats st; unsigned poison;
    __device__ __forceinline__ void fused(f32x4 (&acc)[2][2][4][2], const Unit& u, int wr, int wc, int fr, int fq, PG8_LAS unsigned char* lds, int wid, int lane) const {
        typedef float f32x2v __attribute__((ext_vector_type(2)));
        const PG8_LAS f32x2v* S = (const PG8_LAS f32x2v*)(lds + 8192);
        const int col0 = u.pn * BM + wc * 32 + 4 * fq;
#pragma unroll
        for (int bj = 0; bj < 2; ++bj)
#pragma unroll
            for (int n = 0; n < 2; ++n) { const f32x4 bv = bias ? *(const f32x4*)(bias + col0 + bj * HALF + n * 16) : (f32x4){0.f, 0.f, 0.f, 0.f};
#pragma unroll
                for (int ai = 0; ai < 2; ++ai)
#pragma unroll
                    for (int m = 0; m < 4; ++m) acc[ai][bj][m][n] += bv; }
        f32x4 pre[4][2][2];
#pragma unroll
        for (int m = 0; m < 4; ++m) { const size_t off = (size_t)(u.pm * BM + wr * 64 + m * 16 + fr) * ldc + col0;
#pragma unroll
            for (int bj = 0; bj < 2; ++bj)
#pragma unroll
                for (int n = 0; n < 2; ++n) pre[m][bj][n] = *(const f32x4*)(base + off + bj * HALF + n * 16); }
        const bool bad = st.run(acc, u, wr, wc, fr, fq, lds, wid, lane) || poison != 0u;
        const float qnan = __builtin_nanf("");
#pragma unroll
        for (int ai = 0; ai < 2; ++ai)
#pragma unroll
            for (int m = 0; m < 4; ++m) { const int r = ai * HALF + wr * 64 + m * 16 + fr; const f32x2v sr = S[r]; const size_t off = (size_t)(u.pm * BM + r) * ldc + col0;
#pragma unroll
                for (int bj = 0; bj < 2; ++bj)
#pragma unroll
                    for (int n = 0; n < 2; ++n) { const f32x4 bs = ai == 0 ? pre[m][bj][n] : *(const f32x4*)(base + off + bj * HALF + n * 16); f32x4 o = bs + (acc[ai][bj][m][n] - sr.x) * sr.y;
                        if (bad) o = (f32x4){qnan, qnan, qnan, qnan}; *(f32x4*)(out + off + bj * HALF + n * 16) = o; }
                if (m & 1) asm volatile("" ::: "memory"); }
    }
};
struct EpiLnResLn {
    static constexpr bool PERM = false, AFTER_DRAIN = true;
    const float* base; float* out; bf16_t* xn; int ldc; const float* bias; PanelStats st1, st2; unsigned poison;
    __device__ __forceinline__ void fused(f32x4 (&acc)[2][2][4][2], const Unit& u, int wr, int wc, int fr, int fq, PG8_LAS unsigned char* lds, int wid, int lane) const {
        typedef float f32x2v __attribute__((ext_vector_type(2))); typedef unsigned u32x2v __attribute__((ext_vector_type(2)));
        const PG8_LAS f32x2v* S = (const PG8_LAS f32x2v*)(lds + 8192);
        const int col0 = u.pn * BM + wc * 32 + 4 * fq;
#pragma unroll
        for (int bj = 0; bj < 2; ++bj)
#pragma unroll
            for (int n = 0; n < 2; ++n) { const f32x4 bv = bias ? *(const f32x4*)(bias + col0 + bj * HALF + n * 16) : (f32x4){0.f, 0.f, 0.f, 0.f};
#pragma unroll
                for (int ai = 0; ai < 2; ++ai)
#pragma unroll
                    for (int m = 0; m < 4; ++m) acc[ai][bj][m][n] += bv; }
        bool bad = st1.run(acc, u, wr, wc, fr, fq, lds, wid, lane) || poison != 0u;
        const float qnan = __builtin_nanf("");
#pragma unroll
        for (int ai = 0; ai < 2; ++ai)
#pragma unroll
            for (int m = 0; m < 4; ++m) { const int r = ai * HALF + wr * 64 + m * 16 + fr; const f32x2v sr = S[r]; const size_t off = (size_t)(u.pm * BM + r) * ldc + col0;
#pragma unroll
                for (int bj = 0; bj < 2; ++bj)
#pragma unroll
                    for (int n = 0; n < 2; ++n) { const f32x4 bs = *(const f32x4*)(base + off + bj * HALF + n * 16); acc[ai][bj][m][n] = bs + (acc[ai][bj][m][n] - sr.x) * sr.y; }
                asm volatile("" : "+v"(acc[ai][0][m][0]), "+v"(acc[ai][0][m][1]), "+v"(acc[ai][1][m][0]), "+v"(acc[ai][1][m][1]));
                if (m & 1) asm volatile("" ::: "memory"); }
        const bool bad1 = bad;
        bad = st2.run(acc, u, wr, wc, fr, fq, lds, wid, lane) || bad;
#pragma unroll
        for (int ai = 0; ai < 2; ++ai)
#pragma unroll
            for (int m = 0; m < 4; ++m) { const int r = ai * HALF + wr * 64 + m * 16 + fr; const f32x2v sr = S[r]; const size_t off = (size_t)(u.pm * BM + r) * ldc + col0;
#pragma unroll
                for (int bj = 0; bj < 2; ++bj)
#pragma unroll
                    for (int n = 0; n < 2; ++n) { const f32x4 x1 = acc[ai][bj][m][n]; *(f32x4*)(out + off + bj * HALF + n * 16) = bad1 ? (f32x4){qnan, qnan, qnan, qnan} : x1;
                        const f32x4 o = (x1 - sr.x) * sr.y; u32x2v w; w.x = cvt_pk_bf16(o[0], o[1]); w.y = cvt_pk_bf16(o[2], o[3]);
                        if (bad) { w.x = 0x7fc07fc0u; w.y = 0x7fc07fc0u; } *(u32x2v*)(xn + off + bj * HALF + n * 16) = w; }
                asm volatile("" ::: "memory"); }
    }
};

template <class Epi, class Sched, bool ALIGN_EPI = false, bool SP2 = false>
__device__ __forceinline__ void gemm_phase(PG8_LAS unsigned char* lds, const Gemm g, const Sched& S, const Epi& E) {
    const int tid = threadIdx.x, wid = __builtin_amdgcn_readfirstlane(tid >> 6), lane = tid & 63, wr = wid >> 2, wc = wid & 3, fr = lane & 15, fq = lane >> 4;
    const int K = g.K, nt = K / BK;
    unsigned voffA[2], voffB[2];
#pragma unroll
    for (int i = 0; i < 2; ++i) { int R, C; stage_rc(tid * 16 + i * 8192, R, C); const int Rb = Epi::PERM ? ((R & ~31) + perm32(R & 31)) : R;
        voffA[i] = (unsigned)(R * K + C) * 2u; voffB[i] = (unsigned)(Rb * K + C) * 2u; }
    const size_t kstep = (size_t)(BK * 2);
    const size_t hstep = (size_t)HALF * K * 2;
    const size_t tstep = 2 * hstep;
    const unsigned ldsw = (unsigned)wid * 1024u;
    const int aoff = lds_byte(wr * 64 + fr, fq * 8), boff = lds_byte(wc * 32 + fr, fq * 8);
#define PG8_SA(b, h) (((b) * 2 + (h)) * HTB)
#define PG8_SB(b, h) ((4 + (b) * 2 + (h)) * HTB)
#define PG8_STAGE(bufoff, gbase, voff) do { _Pragma("unroll") for (int _i = 0; _i < 2; ++_i) \
        __builtin_amdgcn_global_load_lds((const unsigned*)((const char*)(gbase) + (voff)[_i]), (PG8_LAS unsigned*)(lds + (bufoff) + ldsw + _i * 8192), 16, 0, 0); } while (0)
#define PG8_LDA(dst, b, h) do { _Pragma("unroll") for (int m = 0; m < 4; ++m) _Pragma("unroll") for (int k = 0; k < 2; ++k) dst[m][k] = *(const PG8_LAS bf16x8*)(lds + PG8_SA(b, h) + aoff + m * 2048 + k * 1024); } while (0)
#define PG8_LDB(dst, b, h) do { _Pragma("unroll") for (int n = 0; n < 2; ++n) _Pragma("unroll") for (int k = 0; k < 2; ++k) dst[n][k] = *(const PG8_LAS bf16x8*)(lds + PG8_SB(b, h) + boff + n * 2048 + k * 1024); } while (0)
#define PG8_MMA(ai, bj, At, Bt) do { __builtin_amdgcn_s_setprio(1); _Pragma("unroll") for (int m = 0; m < 4; ++m) _Pragma("unroll") for (int n = 0; n < 2; ++n) _Pragma("unroll") for (int k = 0; k < 2; ++k) \
        acc[ai][bj][m][n] = __builtin_amdgcn_mfma_f32_16x16x32_bf16(Bt[n][k], At[m][k], acc[ai][bj][m][n], 0, 0, 0); __builtin_amdgcn_s_setprio(0); } while (0)
#define PG8_WAIT_V(n) asm volatile("s_waitcnt vmcnt(" #n ")" ::: "memory")
#define PG8_WAIT_L(n) asm volatile("s_waitcnt lgkmcnt(" #n ")" ::: "memory")
#define PG8_BAR __builtin_amdgcn_s_barrier()
#define PG8_SCHED __builtin_amdgcn_sched_barrier(0)
    Unit cur, nxt; int ui = 0;
    if (!S.next(0, cur)) return;
    f32x4 acc[2][2][4][2];
#pragma unroll
    for (int a = 0; a < 2; ++a)
#pragma unroll
        for (int b = 0; b < 2; ++b)
#pragma unroll
            for (int m = 0; m < 4; ++m)
#pragma unroll
                for (int n = 0; n < 2; ++n) acc[a][b][m][n] = (f32x4){0.f, 0.f, 0.f, 0.f};
    bf16x8 At[4][2], B0[2][2], B1[2][2];
    const char* cA = (const char*)g.A + (size_t)cur.pm * tstep; const char* cB = (const char*)g.Bt + (size_t)cur.pn * tstep;
    S.a_ready(cur);
    if constexpr (SP2) {
        PG8_STAGE(PG8_SB(0, 0), cB, voffB); PG8_STAGE(PG8_SB(0, 1), cB + hstep, voffB); PG8_STAGE(PG8_SA(0, 0), cA, voffA); PG8_STAGE(PG8_SA(0, 1), cA + hstep, voffA);
        if (wr == 1) PG8_BAR;
        PG8_WAIT_V(2); PG8_BAR;
        PG8_STAGE(PG8_SB(1, 0), cB + kstep, voffB); PG8_STAGE(PG8_SA(1, 0), cA + kstep, voffA); PG8_STAGE(PG8_SB(1, 1), cB + hstep + kstep, voffB);
        PG8_WAIT_V(6); PG8_BAR;
    } else {
        PG8_STAGE(PG8_SB(0, 0), cB, voffB); PG8_STAGE(PG8_SA(0, 0), cA, voffA); PG8_STAGE(PG8_SB(0, 1), cB + hstep, voffB); PG8_STAGE(PG8_SA(0, 1), cA + hstep, voffA);
        if (wr == 1) PG8_BAR;
        PG8_WAIT_V(4); PG8_BAR;
        PG8_STAGE(PG8_SB(1, 0), cB + kstep, voffB); PG8_STAGE(PG8_SA(1, 0), cA + kstep, voffA); PG8_STAGE(PG8_SB(1, 1), cB + hstep + kstep, voffB);
        PG8_WAIT_V(6); PG8_BAR;
    }
    for (;;) {
        const bool has_next = S.next(ui + 1, nxt);
        const char* nA = has_next ? (const char*)g.A + (size_t)nxt.pm * tstep : cA; const char* nB = has_next ? (const char*)g.Bt + (size_t)nxt.pn * tstep : cB;
        for (int t = 0; t < nt; t += 2) {
            const bool last = (t == nt - 2);
            const char* a1 = cA + (size_t)(t + 1) * kstep;
            const char* a2 = last ? nA : cA + (size_t)(t + 2) * kstep; const char* b2 = last ? nB : cB + (size_t)(t + 2) * kstep;
            const char* a3 = a2 + kstep; const char* b3 = b2 + kstep;
            if (last && has_next) S.a_ready(nxt);
            if constexpr (SP2) {
            PG8_LDB(B0, 0, 0); PG8_LDB(B1, 0, 1); PG8_SCHED; PG8_LDA(At, 0, 0); PG8_STAGE(PG8_SA(1, 1), a1 + hstep, voffA);
            PG8_WAIT_V(8); PG8_WAIT_L(0); PG8_BAR; PG8_MMA(0, 0, At, B0); PG8_MMA(0, 1, At, B1); PG8_BAR; PG8_SCHED;
            PG8_LDA(At, 0, 1); PG8_STAGE(PG8_SB(0, 0), b2, voffB); PG8_STAGE(PG8_SB(0, 1), b2 + hstep, voffB); PG8_STAGE(PG8_SA(0, 0), a2, voffA);
            PG8_WAIT_V(8); PG8_WAIT_L(0); PG8_BAR; PG8_MMA(1, 0, At, B0); PG8_MMA(1, 1, At, B1); PG8_BAR; PG8_SCHED;
            PG8_LDB(B0, 1, 0); PG8_LDB(B1, 1, 1); PG8_SCHED; PG8_LDA(At, 1, 0); PG8_STAGE(PG8_SA(0, 1), a2 + hstep, voffA);
            PG8_WAIT_V(8); PG8_WAIT_L(0); PG8_BAR; PG8_MMA(0, 0, At, B0); PG8_MMA(0, 1, At, B1); PG8_BAR; PG8_SCHED;
            PG8_LDA(At, 1, 1); PG8_STAGE(PG8_SB(1, 0), b3, voffB); PG8_STAGE(PG8_SB(1, 1), b3 + hstep, voffB); PG8_STAGE(PG8_SA(1, 0), a3, voffA);
            PG8_WAIT_V(8); PG8_WAIT_L(0); PG8_BAR; PG8_MMA(1, 0, At, B0); PG8_MMA(1, 1, At, B1); PG8_BAR; PG8_SCHED;
            } else {
            PG8_LDB(B0, 0, 0); PG8_SCHED; PG8_LDA(At, 0, 0); PG8_STAGE(PG8_SA(1, 1), a1 + hstep, voffA);
            PG8_WAIT_L(8); PG8_BAR; PG8_WAIT_L(0); PG8_MMA(0, 0, At, B0); PG8_BAR; PG8_SCHED;
            PG8_LDB(B1, 0, 1); PG8_STAGE(PG8_SB(0, 0), b2, voffB);
            PG8_BAR; PG8_WAIT_L(0); PG8_MMA(0, 1, At, B1); PG8_BAR;
            PG8_LDA(At, 0, 1); PG8_STAGE(PG8_SA(0, 0), a2, voffA);
            PG8_BAR; PG8_WAIT_L(0); PG8_MMA(1, 0, At, B0); PG8_BAR; PG8_SCHED;
            PG8_STAGE(PG8_SB(0, 1), b2 + hstep, voffB);
            PG8_WAIT_V(6); PG8_BAR; PG8_MMA(1, 1, At, B1); PG8_BAR;
            PG8_LDB(B0, 1, 0); PG8_SCHED; PG8_LDA(At, 1, 0); PG8_STAGE(PG8_SA(0, 1), a2 + hstep, voffA);
            PG8_WAIT_L(8); PG8_BAR; PG8_WAIT_L(0); PG8_MMA(0, 0, At, B0); PG8_BAR; PG8_SCHED;
            PG8_LDB(B1, 1, 1); PG8_STAGE(PG8_SB(1, 0), b3, voffB);
            PG8_BAR; PG8_WAIT_L(0); PG8_MMA(0, 1, At, B1); PG8_BAR;
            PG8_LDA(At, 1, 1); PG8_STAGE(PG8_SA(1, 0), a3, voffA);
            PG8_BAR; PG8_WAIT_L(0); PG8_MMA(1, 0, At, B0); PG8_BAR; PG8_SCHED;
            PG8_STAGE(PG8_SB(1, 1), b3 + hstep, voffB);
            PG8_WAIT_V(6); PG8_BAR; PG8_MMA(1, 1, At, B1); PG8_BAR;
            }
        }
        if constexpr (ALIGN_EPI) { if (wr == 0) PG8_BAR; }
        if constexpr (!Epi::AFTER_DRAIN) { E(acc, cur, wr, wc, fr, fq); S.done(cur); }
        if (!has_next) break;
#pragma unroll
        for (int a = 0; a < 2; ++a)
#pragma unroll
            for (int b = 0; b < 2; ++b)
#pragma unroll
                for (int m = 0; m < 4; ++m)
#pragma unroll
                    for (int n = 0; n < 2; ++n) acc[a][b][m][n] = (f32x4){0.f, 0.f, 0.f, 0.f};
        cur = nxt; cA = nA; cB = nB; ++ui;
        if constexpr (ALIGN_EPI) { if (wr == 1) PG8_BAR; }
    }
    PG8_WAIT_V(0);
    if constexpr (!ALIGN_EPI) { if (wr == 0) PG8_BAR; }
    PG8_BAR;
    if constexpr (Epi::AFTER_DRAIN) { E.fused(acc, cur, wr, wc, fr, fq, lds, wid, lane); S.done(cur); }
#undef PG8_SA
#undef PG8_SB
#undef PG8_STAGE
#undef PG8_LDA
#undef PG8_LDB
#undef PG8_MMA
#undef PG8_WAIT_V
#undef PG8_WAIT_L
#undef PG8_BAR
#undef PG8_SCHED
}
}
#define LAS __attribute__((address_space(3)))
typedef unsigned short bf16;
typedef float f32x4 __attribute__((ext_vector_type(4)));
typedef float f32x16 __attribute__((ext_vector_type(16)));
typedef unsigned u32x4 __attribute__((ext_vector_type(4)));
typedef unsigned u32x2 __attribute__((ext_vector_type(2)));
typedef short bf16x8 __attribute__((ext_vector_type(8)));

#ifndef FAST_SB
#define FAST_SB 1
#endif
#ifndef FAST_GLA
#define FAST_GLA 0
#endif

constexpr int NB = 16, S = 2048, D = 1024, M = NB * S, FF = 4096, NLAYER = 4;
constexpr int GLA_NA = 2304;
constexpr int PQ = 0, PK = 512, PG = 1024, PA1 = 2048;
constexpr float ALPHA = 1.681792830507429f, LN_EPS = 1e-5f, RMS_EPS = 1e-6f;
constexpr float C2_SB = 0.125f * 1.4426950408889634f;
constexpr size_t MiB = 1u << 20;
constexpr size_t WS_WA = 2 * MiB, WS_WV = 7 * MiB, WS_WO = 9 * MiB, WS_WUP = 12 * MiB, WS_WDN = 20 * MiB;
constexpr size_t WS_HB = 32 * MiB, WS_KB = 96 * MiB, WS_VT = 160 * MiB, WS_BIG = 224 * MiB, WS_END = 480 * MiB;
constexpr int LDS_BYTES = 155648;

struct Args { const float* in[13]; float* out; unsigned char* ws; };

__device__ __forceinline__ float bf2f(unsigned x) { return __uint_as_float(x << 16); }
__device__ __forceinline__ unsigned f2bf(float f) { unsigned u = __float_as_uint(f); return (u + 0x7fffu + ((u >> 16) & 1u)) >> 16; }
__device__ __forceinline__ unsigned pk2(float lo, float hi) { return f2bf(lo) | (f2bf(hi) << 16); }
__device__ __forceinline__ float wave_sum(float v) {
#pragma unroll
    for (int o = 1; o < 64; o <<= 1) v += __shfl_xor(v, o);
    return v;
}

namespace pg8 {
template <int ACT  > struct EpiB {
    static constexpr bool PERM = true, AFTER_DRAIN = false;
    bf16_t* O; int ldc; int split_cols; size_t split_stride; float scale0;
    __device__ __forceinline__ void operator()(const f32x4 (&acc)[2][2][4][2], const Unit& u, int wr, int wc, int fr, int fq) const {
        const int row0 = u.pm * BM + wr * 64 + fr; int colt = u.pn * BM; bf16_t* base = O;
        float sc = 1.f; if (split_cols) { const int t = colt / split_cols; base += (size_t)t * split_stride; colt -= t * split_cols; if (t == 0) sc = scale0; }
        const int col0 = colt + wc * 32 + 8 * fq;
#pragma unroll
        for (int ai = 0; ai < 2; ++ai)
#pragma unroll
            for (int m = 0; m < 4; ++m) { bf16_t* rowp = base + (size_t)(row0 + ai * HALF + m * 16) * ldc + col0;
#pragma unroll
                for (int bj = 0; bj < 2; ++bj) { f32x4 v0 = acc[ai][bj][m][0], v1 = acc[ai][bj][m][1];
                    if (ACT == 2) { v0 = __builtin_elementwise_max(v0, (f32x4){0.f, 0.f, 0.f, 0.f}); v1 = __builtin_elementwise_max(v1, (f32x4){0.f, 0.f, 0.f, 0.f}); v0 = v0 * v0; v1 = v1 * v1; }
                    v0 = v0 * sc; v1 = v1 * sc; u32x4 w; w.x = cvt_pk_bf16(v0[0], v0[1]); w.y = cvt_pk_bf16(v0[2], v0[3]); w.z = cvt_pk_bf16(v1[0], v1[1]); w.w = cvt_pk_bf16(v1[2], v1[3]);
                    *(u32x4*)(rowp + bj * HALF) = w; } }
    }
};
struct EpiRes {
    static constexpr bool PERM = false, AFTER_DRAIN = false;
    float* io; int ldc; float alpha;
    __device__ __forceinline__ void operator()(const f32x4 (&acc)[2][2][4][2], const Unit& u, int wr, int wc, int fr, int fq) const {
        const int col0 = u.pn * BM + wc * 32 + 4 * fq;
#pragma unroll
        for (int ai = 0; ai < 2; ++ai)
#pragma unroll
            for (int m = 0; m < 4; ++m) { float* rowp = io + (size_t)(u.pm * BM + ai * HALF + wr * 64 + m * 16 + fr) * ldc + col0;
#pragma unroll
                for (int bj = 0; bj < 2; ++bj)
#pragma unroll
                    for (int n = 0; n < 2; ++n) { f32x4* p = (f32x4*)(rowp + bj * HALF + n * 16); const f32x4 b = *p; *p = b * alpha + acc[ai][bj][m][n]; }
                asm volatile("" ::: "memory"); }
    }
};
}

__device__ __forceinline__ void transpose_item(const float* W, int ldw, int K, bf16* WT, LAS float* scr, int kb, int nb, int lane) {
    const int k0 = 64 * kb, n0 = 32 * nb;
#pragma unroll 8
    for (int i = 0; i < 32; ++i) { const int kk = 2 * i + (lane >> 5); scr[kk * 33 + (lane & 31)] = W[(size_t)(k0 + kk) * ldw + n0 + (lane & 31)]; }
    asm volatile("s_waitcnt lgkmcnt(0)" ::: "memory");
    const int c = lane & 7;
#pragma unroll
    for (int j = 0; j < 4; ++j) { const int n = (lane >> 3) + 8 * j; const LAS float* s = scr + (8 * c) * 33 + n;
        u32x4 o; o.x = pk2(s[0 * 33], s[1 * 33]); o.y = pk2(s[2 * 33], s[3 * 33]); o.z = pk2(s[4 * 33], s[5 * 33]); o.w = pk2(s[6 * 33], s[7 * 33]);
        *(u32x4*)(WT + (size_t)(n0 + n) * K + k0 + 8 * c) = o; }
    asm volatile("s_waitcnt lgkmcnt(0)" ::: "memory");
}
__device__ __forceinline__ void convert_job(const float* W, int ldw, int K, int ncols, bf16* WT, LAS float* scr, int gw, int NGW, int lane) {
    const int nblk = ncols / 32, nitems = (K / 64) * nblk;
    for (int it = gw; it < nitems; it += NGW) transpose_item(W, ldw, K, WT, scr, it / nblk, it % nblk, lane);
}
__device__ __forceinline__ void convert_layer(const Args& a, int L, LAS unsigned char* lds, int wave, int lane, int gw, int NGW) {
    LAS float* scr = (LAS float*)(lds + wave * 16384);
    unsigned char* ws = a.ws;
    bf16* WA = (bf16*)(ws + WS_WA); bf16* WV = (bf16*)(ws + WS_WV); bf16* WO = (bf16*)(ws + WS_WO); bf16* WUP = (bf16*)(ws + WS_WUP); bf16* WDN = (bf16*)(ws + WS_WDN);
    if (L < 2) {
        const float* win = a.in[1] + (size_t)L * D * 3088;
        convert_job(win + 0, 3088, D, 512, WA + (size_t)PQ * D, scr, gw, NGW, lane);
        convert_job(win + 512, 3088, D, 512, WA + (size_t)PK * D, scr, gw, NGW, lane);
        convert_job(win + 2048, 3088, D, 1024, WA + (size_t)PG * D, scr, gw, NGW, lane);
        convert_job(win + 1024, 3088, D, 1024, WV, scr, gw, NGW, lane);
        convert_job(a.in[5] + (size_t)L * D * D, D, D, D, WO, scr, gw, NGW, lane);
        const int gt = gw * 64 + lane, NT = NGW * 64;
        for (int idx = gt; idx < 16 * D; idx += NT) { const int n = idx / D, k = idx % D; WA[(size_t)(PA1 + n) * D + k] = (bf16)f2bf(win[(size_t)k * 3088 + 3072 + n]); }
        for (int idx = gt; idx < 240 * D / 8; idx += NT) ((u32x4*)(WA + (size_t)(PA1 + 16) * D))[idx] = (u32x4){0u, 0u, 0u, 0u};
    } else {
        const int j = L - 2;
        convert_job(a.in[7] + (size_t)j * D * D, D, D, D, WA, scr, gw, NGW, lane);
        if (j == 0) {
            convert_job(a.in[6] + 0, 2 * D, D, D, WA + (size_t)D * D, scr, gw, NGW, lane);
            convert_job(a.in[6] + D, 2 * D, D, D, WV, scr, gw, NGW, lane);
        }
        convert_job(a.in[8] + (size_t)j * D * D, D, D, D, WO, scr, gw, NGW, lane);
    }
    convert_job(a.in[9] + (size_t)L * D * FF, FF, D, FF, WUP, scr, gw, NGW, lane);
    convert_job(a.in[10] + (size_t)L * FF * D, D, FF, D, WDN, scr, gw, NGW, lane);
}

__device__ __forceinline__ void ln_phase(float* hf, bf16* hb, const float* g, const float* b, int gw, int NGW, int lane) {
    f32x4 gv[4], bv[4];
#pragma unroll
    for (int j = 0; j < 4; ++j) { gv[j] = ((const f32x4*)g)[lane + 64 * j]; bv[j] = ((const f32x4*)b)[lane + 64 * j]; }
    for (int m = gw; m < M; m += NGW) {
        f32x4* xr = (f32x4*)(hf + (size_t)m * D) + lane;
        f32x4 v[4]; float s = 0.f;
#pragma unroll
        for (int j = 0; j < 4; ++j) { v[j] = xr[64 * j]; s += (v[j].x + v[j].y) + (v[j].z + v[j].w); }
        const float mean = wave_sum(s) * (1.f / D); float s2 = 0.f;
#pragma unroll
        for (int j = 0; j < 4; ++j) { v[j] = v[j] - mean; s2 += (v[j].x * v[j].x + v[j].y * v[j].y) + (v[j].z * v[j].z + v[j].w * v[j].w); }
        const float rstd = 1.f / sqrtf(wave_sum(s2) * (1.f / D) + LN_EPS);
        u32x2* o8 = (u32x2*)(hb + (size_t)m * D) + lane;
#pragma unroll
        for (int j = 0; j < 4; ++j) { const f32x4 y = v[j] * rstd * gv[j] + bv[j]; xr[64 * j] = y; o8[64 * j] = (u32x2){pk2(y.x, y.y), pk2(y.z, y.w)}; }
    }
}
__device__ __forceinline__ float log_sigmoid_f(float z) { return fminf(z, 0.f) - log1pf(expf(-fabsf(z))); }

__device__ __forceinline__ void sb_naive(const bf16* Q, const bf16* K, const bf16* VT, bf16* O, int gtid, int nthreads) {
    int it = 0;
#pragma unroll 1
    for (int base = 0; base < NB * 16 * S; base += nthreads, ++it) {
        const int task = base + gtid;
        const int bh = __builtin_amdgcn_readfirstlane(task / S), tt = task % S;
        const int t = (it & 1) ? (S - 1 - tt) : tt;
        const int b = bh >> 4, h = bh & 15;
        const int tt0 = __builtin_amdgcn_readfirstlane(tt & ~63);
        const int tmax = (it & 1) ? (S - 1 - tt0) : (tt0 | 63);
        float q[64], o[64];
        { const u32x4* qp = (const u32x4*)(Q + (size_t)(b * S + t) * D + h * 64);
#pragma unroll
          for (int i = 0; i < 8; ++i) { const u32x4 w = qp[i];
              q[8 * i + 0] = bf2f(w.x & 0xffffu); q[8 * i + 1] = bf2f(w.x >> 16); q[8 * i + 2] = bf2f(w.y & 0xffffu); q[8 * i + 3] = bf2f(w.y >> 16);
              q[8 * i + 4] = bf2f(w.z & 0xffffu); q[8 * i + 5] = bf2f(w.z >> 16); q[8 * i + 6] = bf2f(w.w & 0xffffu); q[8 * i + 7] = bf2f(w.w >> 16); } }
#pragma unroll
        for (int d = 0; d < 64; ++d) o[d] = 0.f;
        float P = 1.f;
#pragma unroll 1
        for (int s = tmax - 1; s >= 0; --s) {
            const u32x4* kp = (const u32x4*)(K + (size_t)(b * S + s) * D + h * 64);
            float z = 0.f;
#pragma unroll
            for (int i = 0; i < 8; ++i) { const u32x4 kw = kp[i];
                z += q[8 * i + 0] * bf2f(kw.x & 0xffffu); z += q[8 * i + 1] * bf2f(kw.x >> 16); z += q[8 * i + 2] * bf2f(kw.y & 0xffffu); z += q[8 * i + 3] * bf2f(kw.y >> 16);
                z += q[8 * i + 4] * bf2f(kw.z & 0xffffu); z += q[8 * i + 5] * bf2f(kw.z >> 16); z += q[8 * i + 6] * bf2f(kw.w & 0xffffu); z += q[8 * i + 7] * bf2f(kw.w >> 16); }
            const float e = (s < t) ? exp2f(fminf(z, 100.f)) : 0.f;
            const float r = 1.f / (1.f + e);
            P *= r; const float w = e * P;
            const bf16* vp = VT + (size_t)(h * 64) * M + b * S + s;
#pragma unroll
            for (int d = 0; d < 64; ++d) { o[d] += w * bf2f(vp[(size_t)d * M]); if ((d & 7) == 7) asm volatile("" ::: "memory"); }
        }
        u32x4* op = (u32x4*)(O + (size_t)(b * S + t) * D + h * 64);
#pragma unroll
        for (int i = 0; i < 8; ++i) op[i] = (u32x4){pk2(o[8 * i], o[8 * i + 1]), pk2(o[8 * i + 2], o[8 * i + 3]), pk2(o[8 * i + 4], o[8 * i + 5]), pk2(o[8 * i + 6], o[8 * i + 7])};
    }
}

__device__ __forceinline__ void gla_gate_naive(const bf16* PROJ, const float* wa2, const float* ba, float* A, int gtid, int nthreads) {
    for (int idx = gtid; idx < M * 512; idx += nthreads) {
        const int t = idx >> 9, c = idx & 511;
        float z = ba[c];
        const u32x4* ap = (const u32x4*)(PROJ + (size_t)t * GLA_NA + PA1);
        const u32x4 a0 = ap[0], a1 = ap[1];
        const unsigned aw[8] = {a0.x, a0.y, a0.z, a0.w, a1.x, a1.y, a1.z, a1.w};
#pragma unroll
        for (int r = 0; r < 8; ++r) { z += bf2f(aw[r] & 0xffffu) * wa2[(2 * r) * 512 + c]; z += bf2f(aw[r] >> 16) * wa2[(2 * r + 1) * 512 + c]; }
        A[idx] = expf(log_sigmoid_f(z) * (1.f / 16.f));
    }
}
__device__ __forceinline__ void gla_rec_naive(const bf16* PROJ, const float* A, const bf16* VT, float* OU, int gtid) {
    if (gtid >= NB * 4 * 256) return;
    const int bh = __builtin_amdgcn_readfirstlane(gtid >> 8), e = gtid & 255, b = bh >> 2, h = bh & 3;
    float st[128];
#pragma unroll
    for (int c = 0; c < 128; ++c) st[c] = 0.f;
    const bf16* vt = VT + (size_t)(h * 256 + e) * M + b * S;
    for (int t = 0; t < S; ++t) {
        const size_t row = (size_t)b * S + t;
        const u32x4* qp = (const u32x4*)(PROJ + row * GLA_NA + PQ + h * 128);
        const u32x4* kp = (const u32x4*)(PROJ + row * GLA_NA + PK + h * 128);
        const f32x4* ap = (const f32x4*)(A + row * 512 + h * 128);
        const float v = bf2f(vt[t]);
        float o = 0.f;
#pragma unroll
        for (int i = 0; i < 16; ++i) {
            const u32x4 qw = qp[i], kw = kp[i]; const f32x4 a0 = ap[2 * i], a1 = ap[2 * i + 1];
            const unsigned qa[4] = {qw.x, qw.y, qw.z, qw.w}, ka[4] = {kw.x, kw.y, kw.z, kw.w};
            const float aa[8] = {a0.x, a0.y, a0.z, a0.w, a1.x, a1.y, a1.z, a1.w};
#pragma unroll
            for (int j = 0; j < 4; ++j) {
                const int c = 8 * i + 2 * j;
                st[c] = aa[2 * j] * st[c] + bf2f(ka[j] & 0xffffu) * v;         o += bf2f(qa[j] & 0xffffu) * st[c];
                st[c + 1] = aa[2 * j + 1] * st[c + 1] + bf2f(ka[j] >> 16) * v; o += bf2f(qa[j] >> 16) * st[c + 1];
            }
        }
        OU[row * D + h * 256 + e] = o * 0.08838834764831845f;
    }
}
__device__ __forceinline__ void gla_norm_naive(const float* OU, const bf16* PROJ, const float* ng, bf16* O, int gw, int NGW, int lane) {
    const f32x4 g4 = ((const f32x4*)ng)[lane];
    for (int task = gw; task < M * 4; task += NGW) {
        const int t = task >> 2, h = task & 3;
        const f32x4 v = *(const f32x4*)(OU + (size_t)t * D + h * 256 + 4 * lane);
        const float ss = wave_sum((v.x * v.x + v.y * v.y) + (v.z * v.z + v.w * v.w));
        const float rstd = 1.f / sqrtf(ss * (1.f / 256.f) + RMS_EPS);
        const u32x2 gw2 = *(const u32x2*)(PROJ + (size_t)t * GLA_NA + PG + h * 256 + 4 * lane);
        const float gg[4] = {bf2f(gw2.x & 0xffffu), bf2f(gw2.x >> 16), bf2f(gw2.y & 0xffffu), bf2f(gw2.y >> 16)};
        float y[4];
#pragma unroll
        for (int i = 0; i < 4; ++i) y[i] = v[i] * rstd * g4[i] * (gg[i] / (1.f + expf(-gg[i])));
        *(u32x2*)(O + (size_t)t * D + h * 256 + 4 * lane) = (u32x2){pk2(y[0], y[1]), pk2(y[2], y[3])};
    }
}
constexpr int SBR = 144, SBT = 64 * SBR;
__device__ __forceinline__ void sb_unit(int b, int h, int qb, const bf16* Q, const bf16* K, const bf16* VT, bf16* O, LAS unsigned char* lds) {
    const int tid = threadIdx.x, lane = tid & 63, q = lane & 31, hi = lane >> 5, w = __builtin_amdgcn_readfirstlane(tid >> 6);
    const size_t rowbase = (size_t)b * S;
    const int t = 256 * qb + 32 * w + q;
    bf16x8 qf[4];
    { const bf16* qrow = Q + (rowbase + t) * D + h * 64 + 8 * hi;
#pragma unroll
      for (int ks = 0; ks < 4; ++ks) qf[ks] = *(const bf16x8*)(qrow + 16 * ks); }
    f32x16 o0, o1;
#pragma unroll
    for (int r = 0; r < 16; ++r) { o0[r] = 0.f; o1[r] = 0.f; }
    float carry = 1.f;
    const int NT = 4 * (qb + 1), jw = 4 * qb + (w >> 1);
    const int tl = 32 * (w & 1) + q;
    const int srow = tid >> 3, sch = tid & 7;
    const bf16* kg = K + (rowbase + srow) * D + h * 64 + sch * 8;
    const bf16* vg = VT + (size_t)(h * 64 + srow) * M + rowbase + sch * 8;
    const int soff = srow * SBR + sch * 16;
    const int pi = (q & 0x13) | ((q & 4) << 1) | ((q & 8) >> 1);
    const int koff = pi * SBR + hi * 16, voff = q * SBR + hi * 16;
    { const u32x4 kreg = *(const u32x4*)(kg + (size_t)(NT - 1) * 64 * D), vreg = *(const u32x4*)(vg + (NT - 1) * 64);
      const int bo = ((NT - 1) & 1) * SBT;
      *(LAS u32x4*)(lds + bo + soff) = kreg; *(LAS u32x4*)(lds + 2 * SBT + bo + soff) = vreg; }
#pragma unroll 1
    for (int j = NT - 1; j >= 0; --j) {
        const int bo = (j & 1) * SBT;
        __syncthreads();
        u32x4 kreg, vreg;
        if (j > 0) { kreg = *(const u32x4*)(kg + (size_t)(j - 1) * 64 * D); vreg = *(const u32x4*)(vg + (j - 1) * 64); }
        if (j <= jw) {
            const LAS unsigned char* kb = lds + bo + koff; const LAS unsigned char* vb = lds + 2 * SBT + bo + voff;
            f32x16 p[2];
#pragma unroll
            for (int r = 0; r < 16; ++r) { p[0][r] = 0.f; p[1][r] = 0.f; }
#pragma unroll
            for (int ks = 0; ks < 4; ++ks) {
                const bf16x8 a0 = *(const LAS bf16x8*)(kb + ks * 32), a1 = *(const LAS bf16x8*)(kb + 32 * SBR + ks * 32);
                p[0] = __builtin_amdgcn_mfma_f32_32x32x16_bf16(a0, qf[ks], p[0], 0, 0, 0);
                p[1] = __builtin_amdgcn_mfma_f32_32x32x16_bf16(a1, qf[ks], p[1], 0, 0, 0);
            }
            float e[2][16], Lc[2][16];
            const bool diag = (j == jw);
#pragma unroll
            for (int blk = 0; blk < 2; ++blk)
#pragma unroll
                for (int r = 0; r < 16; ++r) {
                    float ev = __builtin_amdgcn_exp2f(fminf(p[blk][r], 100.f));
                    const int kl = 32 * blk + 16 * (r >> 3) + 8 * hi + (r & 7);
                    if (diag && kl >= tl) ev = 0.f;
                    e[blk][r] = ev;
                    Lc[blk][r] = __builtin_amdgcn_rcpf(1.f + ev);
                }
#pragma unroll
            for (int blk = 0; blk < 2; ++blk)
#pragma unroll
                for (int a = 0; a < 2; ++a)
#pragma unroll
                    for (int i = 6; i >= 0; --i) Lc[blk][8 * a + i] *= Lc[blk][8 * a + i + 1];
            float Gl[4], Gh[4];
#pragma unroll
            for (int m = 0; m < 4; ++m) { const unsigned gx = __float_as_uint(Lc[m >> 1][8 * (m & 1)]);
                auto rr = __builtin_amdgcn_permlane32_swap(gx, gx, false, false); Gl[m] = __uint_as_float(rr[0]); Gh[m] = __uint_as_float(rr[1]); }
            float Town[4]; float T = carry;
#pragma unroll
            for (int m = 3; m >= 0; --m) { const float Th = T; const float Tl = Th * Gh[m]; Town[m] = hi ? Th : Tl; T = Tl * Gl[m]; }
            carry = T;
            bf16x8 wp[4];
#pragma unroll
            for (int m = 0; m < 4; ++m) {
                const int blk = m >> 1, a = m & 1; float wv[8];
#pragma unroll
                for (int i = 0; i < 8; ++i) wv[i] = e[blk][8 * a + i] * Lc[blk][8 * a + i] * Town[m];
                u32x4 pk; pk.x = pg8::cvt_pk_bf16(wv[0], wv[1]); pk.y = pg8::cvt_pk_bf16(wv[2], wv[3]); pk.z = pg8::cvt_pk_bf16(wv[4], wv[5]); pk.w = pg8::cvt_pk_bf16(wv[6], wv[7]);
                wp[m] = __builtin_bit_cast(bf16x8, pk);
            }
#pragma unroll
            for (int m = 0; m < 4; ++m) {
                const bf16x8 v0 = *(const LAS bf16x8*)(vb + m * 32), v1 = *(const LAS bf16x8*)(vb + 32 * SBR + m * 32);
                o0 = __builtin_amdgcn_mfma_f32_32x32x16_bf16(v0, wp[m], o0, 0, 0, 0);
                o1 = __builtin_amdgcn_mfma_f32_32x32x16_bf16(v1, wp[m], o1, 0, 0, 0);
            }
        }
        if (j > 0) { const int bn = ((j - 1) & 1) * SBT; *(LAS u32x4*)(lds + bn + soff) = kreg; *(LAS u32x4*)(lds + 2 * SBT + bn + soff) = vreg; }
    }
    bf16* orow = O + (rowbase + t) * D + h * 64 + 4 * hi;
#pragma unroll
    for (int g = 0; g < 4; ++g) {
        *(u32x2*)(orow + 8 * g) = (u32x2){pg8::cvt_pk_bf16(o0[4 * g], o0[4 * g + 1]), pg8::cvt_pk_bf16(o0[4 * g + 2], o0[4 * g + 3])};
        *(u32x2*)(orow + 32 + 8 * g) = (u32x2){pg8::cvt_pk_bf16(o1[4 * g], o1[4 * g + 1]), pg8::cvt_pk_bf16(o1[4 * g + 2], o1[4 * g + 3])};
    }
    __syncthreads();
}
__device__ __forceinline__ void sb_phase(const bf16* Q, const bf16* K, const bf16* VT, bf16* O, LAS unsigned char* lds) {
    for (int bh = blockIdx.x; bh < NB * 16; bh += gridDim.x)
#pragma unroll 1
        for (int qb = 7; qb >= 0; --qb) sb_unit(bh >> 4, bh & 15, qb, Q, K, VT, O, lds);
}
template <int L> __device__ __forceinline__ void run_layer(const Args& a, cg::grid_group& grid, LAS unsigned char* lds) {
    const int tid = threadIdx.x, lane = tid & 63, wave = __builtin_amdgcn_readfirstlane(tid >> 6);
    const int G = gridDim.x, gw = blockIdx.x * 8 + wave, NGW = G * 8, gtid = blockIdx.x * 512 + tid, NTH = G * 512;
    unsigned char* ws = a.ws;
    bf16* WA = (bf16*)(ws + WS_WA); bf16* WV = (bf16*)(ws + WS_WV); bf16* WO = (bf16*)(ws + WS_WO); bf16* WUP = (bf16*)(ws + WS_WUP); bf16* WDN = (bf16*)(ws + WS_WDN);
    bf16* HB = (bf16*)(ws + WS_HB); bf16* KB = (bf16*)(ws + WS_KB); bf16* VT = (bf16*)(ws + WS_VT); bf16* BIG = (bf16*)(ws + WS_BIG);
    float* HF = a.out;
    (void)gtid; (void)NTH; (void)WV; (void)KB;
        bf16* OB;
        if constexpr (L < 2) {
            bf16* PROJ = BIG;
            { pg8::Gemm g{HB, WA, M, GLA_NA, D}; pg8::StaticOrder So; So.init(M, GLA_NA, G, (int)blockIdx.x);
              pg8::EpiB<0> E{PROJ, GLA_NA, 0, 0, 1.f};
              pg8::gemm_phase<pg8::EpiB<0>, pg8::StaticOrder, true, true>(lds, g, So, E); }
            { pg8::Gemm g{WV, HB, D, M, D}; pg8::StaticOrder So; So.init(D, M, G, (int)blockIdx.x);
              pg8::EpiB<0> E{VT, M, 0, 0, 1.f};
              pg8::gemm_phase<pg8::EpiB<0>, pg8::StaticOrder, true, true>(lds, g, So, E); }
            grid.sync();
            const float* wa2 = a.in[2] + (size_t)L * 16 * 512; const float* ba = a.in[3] + (size_t)L * 512; const float* ng = a.in[4] + (size_t)L * 256;
#if FAST_GLA
            OB = KB;
#else
            float* AG = (float*)(ws + WS_BIG + 144 * MiB); float* OU = (float*)(ws + WS_HB); OB = VT;
            gla_gate_naive(PROJ, wa2, ba, AG, gtid, NTH);
            grid.sync();
            gla_rec_naive(PROJ, AG, VT, OU, gtid);
            grid.sync();
            gla_norm_naive(OU, PROJ, ng, OB, gw, NGW, lane);
#endif
            grid.sync();
        } else {
            constexpr int j = L - 2;
            bf16* QB = BIG; OB = BIG + (size_t)M * D;
            { const int N = (j == 0) ? 2 * D : D;
              pg8::Gemm g{HB, WA, M, N, D}; pg8::StaticOrder So; So.init(M, N, G, (int)blockIdx.x);
              pg8::EpiB<0> E{QB, D, D, (size_t)(KB - QB), C2_SB};
              pg8::gemm_phase<pg8::EpiB<0>, pg8::StaticOrder, true, true>(lds, g, So, E); }
            if constexpr (j == 0) { pg8::Gemm g{WV, HB, D, M, D}; pg8::StaticOrder So; So.init(D, M, G, (int)blockIdx.x);
              pg8::EpiB<0> E{VT, M, 0, 0, 1.f};
              pg8::gemm_phase<pg8::EpiB<0>, pg8::StaticOrder, true, true>(lds, g, So, E); }
            grid.sync();
#if FAST_SB
            sb_phase(QB, KB, VT, OB, lds);
#else
            sb_naive(QB, KB, VT, OB, gtid, NTH);
#endif
            grid.sync();
        }
        { pg8::Gemm g{OB, WO, M, D, D}; pg8::StaticOrder So; So.init(M, D, G, (int)blockIdx.x);
          pg8::EpiRes E{HF, D, ALPHA};
          pg8::gemm_phase<pg8::EpiRes, pg8::StaticOrder, true, true>(lds, g, So, E); }
        grid.sync();
        ln_phase(HF, HB, a.in[11] + (size_t)(L * 2 + 0) * D, a.in[12] + (size_t)(L * 2 + 0) * D, gw, NGW, lane);
        grid.sync();
        { pg8::Gemm g{HB, WUP, M, FF, D}; pg8::StaticOrder So; So.init(M, FF, G, (int)blockIdx.x);
          pg8::EpiB<2> E{BIG, FF, 0, 0, 1.f};
          pg8::gemm_phase<pg8::EpiB<2>, pg8::StaticOrder, true, true>(lds, g, So, E); }
        grid.sync();
        { pg8::Gemm g{BIG, WDN, M, D, FF}; pg8::StaticOrder So; So.init(M, D, G, (int)blockIdx.x);
          pg8::EpiRes E{HF, D, ALPHA};
          pg8::gemm_phase<pg8::EpiRes, pg8::StaticOrder, true, true>(lds, g, So, E); }
        grid.sync();
        ln_phase(HF, HB, a.in[11] + (size_t)(L * 2 + 1) * D, a.in[12] + (size_t)(L * 2 + 1) * D, gw, NGW, lane);
        if constexpr (L + 1 < NLAYER) { convert_layer(a, L + 1, lds, wave, lane, gw, NGW); grid.sync(); }
}

__global__ void __launch_bounds__(512, 2) yoco_fwd(Args a) {
    extern __shared__ __attribute__((aligned(16))) unsigned char lds_raw[];
    cg::grid_group grid = cg::this_grid();
    LAS unsigned char* lds = (LAS unsigned char*)lds_raw;
    const int tid = threadIdx.x, lane = tid & 63, wave = __builtin_amdgcn_readfirstlane(tid >> 6);
    const int G = gridDim.x, gw = blockIdx.x * 8 + wave, NGW = G * 8, gtid = blockIdx.x * 512 + tid, NTH = G * 512;
    unsigned char* ws = a.ws;
    bf16* WA = (bf16*)(ws + WS_WA); bf16* WV = (bf16*)(ws + WS_WV); bf16* WO = (bf16*)(ws + WS_WO); bf16* WUP = (bf16*)(ws + WS_WUP); bf16* WDN = (bf16*)(ws + WS_WDN);
    bf16* HB = (bf16*)(ws + WS_HB); bf16* KB = (bf16*)(ws + WS_KB); bf16* VT = (bf16*)(ws + WS_VT); bf16* BIG = (bf16*)(ws + WS_BIG);
    float* HF = a.out;

    convert_layer(a, 0, lds, wave, lane, gw, NGW);
    { const f32x4* xs = (const f32x4*)a.in[0]; f32x4* hd = (f32x4*)HF; u32x2* hb = (u32x2*)HB;
      for (int i = gtid; i < M * D / 4; i += NTH) { const f32x4 v = xs[i]; hd[i] = v; hb[i] = (u32x2){pk2(v.x, v.y), pk2(v.z, v.w)}; } }
    grid.sync();

    run_layer<0>(a, grid, lds);
    run_layer<1>(a, grid, lds);
    run_layer<2>(a, grid, lds);
    run_layer<3>(a, grid, lds);
}

extern "C" void kernel_launch(void* const* d_in, const int* in_sizes, int n_in, void* d_out, int out_size, void* d_ws, size_t ws_size, hipStream_t stream) {
    static int grid = 0;
    if (grid == 0) {
        if (n_in != 13 || out_size != M * D || ws_size < WS_END) { fprintf(stderr, "kernel_launch: unexpected shapes (n_in %d out %d ws %zu)\n", n_in, out_size, ws_size); grid = -1; return; }
        int dev = 0, cus = 0, per_cu = 0;
        hipGetDevice(&dev); hipDeviceGetAttribute(&cus, hipDeviceAttributeMultiprocessorCount, dev);
        hipFuncSetAttribute((const void*)yoco_fwd, hipFuncAttributeMaxDynamicSharedMemorySize, LDS_BYTES);
        hipOccupancyMaxActiveBlocksPerMultiprocessor(&per_cu, (const void*)yoco_fwd, 512, LDS_BYTES);
        if (per_cu < 1) { fprintf(stderr, "kernel_launch: occupancy query says %d blocks/CU\n", per_cu); per_cu = 1; }
        (void)hipGetLastError();
        grid = cus * 1;
    }
    if (grid < 0) return;
    Args a{};
    for (int i = 0; i < 13; ++i) a.in[i] = (const float*)d_in[i];
    a.out = (float*)d_out; a.ws = (unsigned char*)d_ws;
    void* args[] = {&a};
    hipError_t e = hipLaunchCooperativeKernel((const void*)yoco_fwd, dim3(grid), dim3(512), args, LDS_BYTES, stream);
    if (e != hipSuccess) fprintf(stderr, "cooperative launch failed: %s (grid %d)\n", hipGetErrorString(e), grid);
}
```

```cpp
#include <hip/hip_runtime.h>
#include <hip/hip_cooperative_groups.h>
#include <cstdio>
#include <cstdint>
namespace cg = cooperative_groups;
namespace pg8 {
#define PG8_LAS __attribute__((address_space(3)))
typedef unsigned short bf16_t;
typedef short bf16x8 __attribute__((ext_vector_type(8)));
typedef float f32x4 __attribute__((ext_vector_type(4)));
typedef unsigned u32x4 __attribute__((ext_vector_type(4)));
constexpr int BM = 256, BK = 64, HALF = 128, HTB = HALF * BK * 2  , STAGE_BYTES = 8 * HTB, NXCD = 8, WGM = 8;

__host__ __device__ __forceinline__ int lds_byte(int r, int c) { const int st = (r >> 4) * 2 + (c >> 5), rr = r & 15, cc = c & 31, ob = rr * 64 + cc * 2; return st * 1024 + (ob ^ (((ob >> 9) & 1) << 5)); }
__host__ __device__ __forceinline__ void stage_rc(int b, int& R, int& C) { const int st = b / 1024, sb = b % 1024, swz = sb ^ (((sb >> 9) & 1) << 5); R = (st >> 1) * 16 + swz / 64; C = (st & 1) * 32 + (swz % 64) / 2; }
__host__ __device__ __forceinline__ int perm32(int rho) { const int n = rho >> 4, i = rho & 15; return 8 * (i >> 2) + 4 * n + (i & 3); }

struct Unit { int pm, pn; };
struct Gemm { const bf16_t* A; const bf16_t* Bt; int M, N, K; };

struct StaticOrder {
    int nM, nN, nwg, G, c;
    __host__ __device__ void init(int M, int N, int G_, int c_) { nM = M / BM; nN = N / BM; nwg = nM * nN; G = G_; c = c_; }
    __host__ __device__ bool next(int i, Unit& u) const {
        const long L = (long)i * G + c; if (L >= nwg) return false;
        int wgid = (int)L; { const int q = nwg / NXCD, r = nwg % NXCD, xcd = wgid % NXCD, off = wgid / NXCD; wgid = (xcd < r ? xcd * (q + 1) : r * (q + 1) + (xcd - r) * q) + off; }
        const int nig = WGM * nN, gid = wgid / nig, fm = gid * WGM, gsz = (nM - fm) < WGM ? (nM - fm) : WGM;
        u.pm = fm + ((wgid % nig) % gsz); u.pn = (wgid % nig) / gsz; return true;
    }
    __device__ __forceinline__ void a_ready(const Unit&) const {}
    __device__ __forceinline__ void done(const Unit&) const {}
};

__device__ __forceinline__ unsigned cvt_pk_bf16(float lo, float hi) { unsigned r; asm volatile("v_cvt_pk_bf16_f32 %0, %1, %2" : "=v"(r) : "v"(lo), "v"(hi)); return r; }
typedef float f32x2 __attribute__((ext_vector_type(2)));
__device__ __forceinline__ f32x2 gelu_pk(f32x2 v) {
    const f32x2 av = __builtin_elementwise_abs(v), d = av * 0.2316418882f + 1.0f;
    f32x2 t; t.x = __builtin_amdgcn_rcpf(d.x); t.y = __builtin_amdgcn_rcpf(d.y);
    f32x2 q = t * 0.5307027145f + (-0.7265760135f); q = q * t + 0.7107068705f; q = q * t + (-0.142248368f); q = q * t + 0.127414796f; q = q * t;
    const f32x2 s = (v * v) * (-0.72134752044f);
    f32x2 e; e.x = __builtin_amdgcn_exp2f(s.x); e.y = __builtin_amdgcn_exp2f(s.y);
    const f32x2 m = v * (q * e), r = v - m;
    f32x2 o; o.x = v.x < 0.f ? m.x : r.x; o.y = v.y < 0.f ? m.y : r.y; return o;
}

template <int ACT  > struct EpiBf16 {
    static constexpr bool PERM = true, AFTER_DRAIN = false; static_assert(ACT == 0 || ACT == 1, "EpiBf16: ACT is 0 (none) or 1 (gelu_pk)");
    bf16_t* O; int ldc; const float* bias; int split_cols; size_t split_stride; float scale0;
    __device__ __forceinline__ void operator()(const f32x4 (&acc)[2][2][4][2], const Unit& u, int wr, int wc, int fr, int fq) const {
        const int row0 = u.pm * BM + wr * 64 + fr; int colt = u.pn * BM; bf16_t* base = O;
        float sc = 1.f; if (split_cols) { const int t = colt / split_cols; base += (size_t)t * split_stride; colt -= t * split_cols; if (t == 0) sc = scale0; }
        const int col0 = colt + wc * 32 + 8 * fq, bcol0 = u.pn * BM + wc * 32 + 8 * fq;
        f32x4 bv[2][2];
#pragma unroll
        for (int bj = 0; bj < 2; ++bj)
#pragma unroll
            for (int n = 0; n < 2; ++n) bv[bj][n] = bias ? *(const f32x4*)(bias + bcol0 + bj * HALF + 4 * n) : (f32x4){0.f, 0.f, 0.f, 0.f};
#pragma unroll
        for (int ai = 0; ai < 2; ++ai)
#pragma unroll
            for (int m = 0; m < 4; ++m) { bf16_t* rowp = base + (size_t)(row0 + ai * HALF + m * 16) * ldc + col0;
#pragma unroll
                for (int bj = 0; bj < 2; ++bj) { f32x4 v0 = acc[ai][bj][m][0] + bv[bj][0], v1 = acc[ai][bj][m][1] + bv[bj][1];
                    if (ACT == 1) { f32x2 a = gelu_pk((f32x2){v0[0], v0[1]}), b = gelu_pk((f32x2){v0[2], v0[3]}), c = gelu_pk((f32x2){v1[0], v1[1]}), d = gelu_pk((f32x2){v1[2], v1[3]});
                        v0 = (f32x4){a.x, a.y, b.x, b.y}; v1 = (f32x4){c.x, c.y, d.x, d.y}; }
                    v0 = v0 * sc; v1 = v1 * sc; u32x4 w; w.x = cvt_pk_bf16(v0[0], v0[1]); w.y = cvt_pk_bf16(v0[2], v0[3]); w.z = cvt_pk_bf16(v1[0], v1[1]); w.w = cvt_pk_bf16(v1[2], v1[3]);
                    *(u32x4*)(rowp + bj * HALF) = w; } }
    }
};

struct PanelStats {
    unsigned* xbuf;
    unsigned* cnt;
    unsigned* tmo;
    int ntn; float eps;
    unsigned code;
    __device__ __forceinline__ bool run(const f32x4 (&v)[2][2][4][2], const Unit& u, int wr, int wc, int fr, int fq, PG8_LAS unsigned char* lds, int wid, int lane) const {
        typedef float f32x2v __attribute__((ext_vector_type(2)));
        PG8_LAS f32x2v* P = (PG8_LAS f32x2v*)lds;
        PG8_LAS f32x2v* S = (PG8_LAS f32x2v*)(lds + 8192);
        PG8_LAS unsigned* flag = (PG8_LAS unsigned*)(lds + 8192 + 2048);
#pragma unroll
        for (int ai = 0; ai < 2; ++ai)
#pragma unroll
            for (int m = 0; m < 4; ++m) {
                float s = 0.f;
#pragma unroll
                for (int bj = 0; bj < 2; ++bj)
#pragma unroll
                    for (int n = 0; n < 2; ++n) { const f32x4 x = v[ai][bj][m][n]; s += (x[0] + x[1]) + (x[2] + x[3]); }
                s += __shfl_xor(s, 16); s += __shfl_xor(s, 32);
                const float mw = s * (1.0f / 64.0f); float q = 0.f;
#pragma unroll
                for (int bj = 0; bj < 2; ++bj)
#pragma unroll
                    for (int n = 0; n < 2; ++n) { const f32x4 d = v[ai][bj][m][n] - mw; q += (d[0] * d[0] + d[1] * d[1]) + (d[2] * d[2] + d[3] * d[3]); }
                q += __shfl_xor(q, 16); q += __shfl_xor(q, 32);
                if (fq == 0) P[(ai * HALF + wr * 64 + m * 16 + fr) * 4 + wc] = (f32x2v){mw, q};
            }
        asm volatile("s_waitcnt lgkmcnt(0)" ::: "memory"); __builtin_amdgcn_s_barrier(); asm volatile("" ::: "memory");
#if defined(BROKEN_EXCHANGE_NO_WAIT)
#warning BROKEN CONTROL BUILD: the row-statistics exchange does not wait; results are wrong by design
        if (blockIdx.x >= 64) { const long long t0_ = clock64(); while (clock64() - t0_ < 60000) __builtin_amdgcn_s_sleep(8); }
#endif
        const int row = wid * 32 + (lane & 31);
        if (lane < 32) {
            const f32x2v a = P[row * 4 + 0], b = P[row * 4 + 1], c = P[row * 4 + 2], d = P[row * 4 + 3];
            const float mt = (a.x + b.x + c.x + d.x) * 0.25f;
            const float da = a.x - mt, db = b.x - mt, dc = c.x - mt, dd = d.x - mt;
            const float m2 = (a.y + b.y) + (c.y + d.y) + 64.0f * ((da * da + db * db) + (dc * dc + dd * dd));
            unsigned long long* slot = (unsigned long long*)xbuf + ((size_t)(u.pm * BM + row) * 4 + u.pn);
            __hip_atomic_store(slot, ((unsigned long long)__float_as_uint(m2) << 32) | __float_as_uint(mt), __ATOMIC_RELAXED, __HIP_MEMORY_SCOPE_AGENT);
        }
        asm volatile("s_waitcnt vmcnt(0)" ::: "memory");
        if (lane == 0) __hip_atomic_fetch_add(cnt + 64 * u.pm, 1u, __ATOMIC_RELAXED, __HIP_MEMORY_SCOPE_AGENT);
        if (wid == 0) {
            bool dead = false; const unsigned long long t0 = __builtin_amdgcn_s_memrealtime(); const unsigned want = 8u * (unsigned)ntn;
            for (;;) {
#if defined(BROKEN_EXCHANGE_NO_WAIT)
                break;
#endif
                if ((unsigned)__builtin_amdgcn_readfirstlane(__hip_atomic_load(cnt + 64 * u.pm, __ATOMIC_RELAXED, __HIP_MEMORY_SCOPE_AGENT)) >= want) break;
                if (__builtin_amdgcn_s_memrealtime() - t0 > 2000000ull) {
                    if (lane == 0) { unsigned expect = 0u; __hip_atomic_compare_exchange_strong(tmo + 1, &expect, code | (unsigned)(u.pm & 0xff), __ATOMIC_RELAXED, __ATOMIC_RELAXED, __HIP_MEMORY_SCOPE_AGENT);
                                     __hip_atomic_store(tmo, 1u, __ATOMIC_RELAXED, __HIP_MEMORY_SCOPE_AGENT); }
                    dead = true; break; }
                __builtin_amdgcn_s_sleep(2);
            }
            __builtin_amdgcn_fence(__ATOMIC_ACQUIRE, "agent");
            if (lane == 0) flag[0] = dead ? 1u : 0u;
        }
        asm volatile("s_waitcnt vmcnt(0) lgkmcnt(0)" ::: "memory"); __builtin_amdgcn_s_barrier(); asm volatile("" ::: "memory");
        const bool bad = flag[0] != 0u;
        if (lane < 32) {
            const unsigned long long* slot = (const unsigned long long*)xbuf + (size_t)(u.pm * BM + row) * 4; float mt[4], m2[4]; float ms = 0.f;
#pragma unroll
            for (int t = 0; t < 4; ++t) { if (t < ntn) { const unsigned long long w = __hip_atomic_load(slot + t, __ATOMIC_RELAXED, __HIP_MEMORY_SCOPE_AGENT); mt[t] = __uint_as_float((unsigned)w); m2[t] = __uint_as_float((unsigned)(w >> 32)); } else { mt[t] = 0.f; m2[t] = 0.f; } ms += mt[t]; }
            const float mean = ms / (float)ntn; float q = 0.f;
#pragma unroll
            for (int t = 0; t < 4; ++t) if (t < ntn) { const float dm = mt[t] - mean; q += m2[t] + 256.0f * dm * dm; }
            S[row] = (f32x2v){mean, 1.0f / sqrtf(q / (256.0f * (float)ntn) + eps)};
        }
        asm volatile("s_waitcnt lgkmcnt(0)" ::: "memory"); __builtin_amdgcn_s_barrier(); asm volatile("" ::: "memory");
        return bad;
    }
};
struct EpiLnRes {
    static constexpr bool PERM = false, AFTER_DRAIN = true;
    const float* base; float* out; int ldc; const float* bias; PanelStats st; unsigned poison;
    __device__ __forceinline__ void fused(f32x4 (&acc)[2][2][4][2], const Unit& u, int wr, int wc, int fr, int fq, PG8_LAS unsigned char* lds, int wid, int lane) const {
        typedef float f32x2v __attribute__((ext_vector_type(2)));
        const PG8_LAS f32x2v* S = (const PG8_LAS f32x2v*)(lds + 8192);
        const int col0 = u.pn * BM + wc * 32 + 4 * fq;
#pragma unroll
        for (int bj = 0; bj < 2; ++bj)
#pragma unroll
            for (int n = 0; n < 2; ++n) { const f32x4 bv = bias ? *(const f32x4*)(bias + col0 + bj * HALF + n * 16) : (f32x4){0.f, 0.f, 0.f, 0.f};
#pragma unroll
                for (int ai = 0; ai < 2; ++ai)
#pragma unroll
                    for (int m = 0; m < 4; ++m) acc[ai][bj][m][n] += bv; }
        f32x4 pre[4][2][2];
#pragma unroll
        for (int m = 0; m < 4; ++m) { const size_t off = (size_t)(u.pm * BM + wr * 64 + m * 16 + fr) * ldc + col0;
#pragma unroll
            for (int bj = 0; bj < 2; ++bj)
#pragma unroll
                for (int n = 0; n < 2; ++n) pre[m][bj][n] = *(const f32x4*)(base + off + bj * HALF + n * 16); }
        const bool bad = st.run(acc, u, wr, wc, fr, fq, lds, wid, lane) || poison != 0u;
        const float qnan = __builtin_nanf("");
#pragma unroll
        for (int ai = 0; ai < 2; ++ai)
#pragma unroll
            for (int m = 0; m < 4; ++m) { const int r = ai * HALF + wr * 64 + m * 16 + fr; const f32x2v sr = S[r]; const size_t off = (size_t)(u.pm * BM + r) * ldc + col0;
#pragma unroll
                for (int bj = 0; bj < 2; ++bj)
#pragma unroll
                    for (int n = 0; n < 2; ++n) { const f32x4 bs = ai == 0 ? pre[m][bj][n] : *(const f32x4*)(base + off + bj * HALF + n * 16); f32x4 o = bs + (acc[ai][bj][m][n] - sr.x) * sr.y;
                        if (bad) o = (f32x4){qnan, qnan, qnan, qnan}; *(f32x4*)(out + off + bj * HALF + n * 16) = o; }
                if (m & 1) asm volatile("" ::: "memory"); }
    }
};
struct EpiLnResLn {
    static constexpr bool PERM = false, AFTER_DRAIN = true;
    const float* base; float* out; bf16_t* xn; int ldc; const float* bias; PanelStats st1, st2; unsigned poison;
    __device__ __forceinline__ void fused(f32x4 (&acc)[2][2][4][2], const Unit& u, int wr, int wc, int fr, int fq, PG8_LAS unsigned char* lds, int wid, int lane) const {
        typedef float f32x2v __attribute__((ext_vector_type(2))); typedef unsigned u32x2v __attribute__((ext_vector_type(2)));
        const PG8_LAS f32x2v* S = (const PG8_LAS f32x2v*)(lds + 8192);
        const int col0 = u.pn * BM + wc * 32 + 4 * fq;
#pragma unroll
        for (int bj = 0; bj < 2; ++bj)
#pragma unroll
            for (int n = 0; n < 2; ++n) { const f32x4 bv = bias ? *(const f32x4*)(bias + col0 + bj * HALF + n * 16) : (f32x4){0.f, 0.f, 0.f, 0.f};
#pragma unroll
                for (int ai = 0; ai < 2; ++ai)
#pragma unroll
                    for (int m = 0; m < 4; ++m) acc[ai][bj][m][n] += bv; }
        bool bad = st1.run(acc, u, wr, wc, fr, fq, lds, wid, lane) || poison != 0u;
        const float qnan = __builtin_nanf("");
#pragma unroll
        for (int ai = 0; ai < 2; ++ai)
#pragma unroll
            for (int m = 0; m < 4; ++m) { const int r = ai * HALF + wr * 64 + m * 16 + fr; const f32x2v sr = S[r]; const size_t off = (size_t)(u.pm * BM + r) * ldc + col0;
#pragma unroll
                for (int bj = 0; bj < 2; ++bj)
#pragma unroll
                    for (int n = 0; n < 2; ++n) { const f32x4 bs = *(const f32x4*)(base + off + bj * HALF + n * 16); acc[ai][bj][m][n] = bs + (acc[ai][bj][m][n] - sr.x) * sr.y; }
                asm volatile("" : "+v"(acc[ai][0][m][0]), "+v"(acc[ai][0][m][1]), "+v"(acc[ai][1][m][0]), "+v"(acc[ai][1][m][1]));
                if (m & 1) asm volatile("" ::: "memory"); }
        const bool bad1 = bad;
        bad = st2.run(acc, u, wr, wc, fr, fq, lds, wid, lane) || bad;
#pragma unroll
        for (int ai = 0; ai < 2; ++ai)
#pragma unroll
            for (int m = 0; m < 4; ++m) { const int r = ai * HALF + wr * 64 + m * 16 + fr; const f32x2v sr = S[r]; const size_t off = (size_t)(u.pm * BM + r) * ldc + col0;
#pragma unroll
                for (int bj = 0; bj < 2; ++bj)
#pragma unroll
                    for (int n = 0; n < 2; ++n) { const f32x4 x1 = acc[ai][bj][m][n]; *(f32x4*)(out + off + bj * HALF + n * 16) = bad1 ? (f32x4){qnan, qnan, qnan, qnan} : x1;
                        const f32x4 o = (x1 - sr.x) * sr.y; u32x2v w; w.x = cvt_pk_bf16(o[0], o[1]); w.y = cvt_pk_bf16(o[2], o[3]);
                        if (bad) { w.x = 0x7fc07fc0u; w.y = 0x7fc07fc0u; } *(u32x2v*)(xn + off + bj * HALF + n * 16) = w; }
                asm volatile("" ::: "memory"); }
    }
};

template <class Epi, class Sched, bool ALIGN_EPI = false, bool SP2 = false>
__device__ __forceinline__ void gemm_phase(PG8_LAS unsigned char* lds, const Gemm g, const Sched& S, const Epi& E) {
    int tid_ = threadIdx.x; asm volatile("" : "+v"(tid_)); const int tid = tid_, wid = __builtin_amdgcn_readfirstlane(tid >> 6), lane = tid & 63, wr = wid >> 2, wc = wid & 3, fr = lane & 15, fq = lane >> 4;
    const int K = g.K, nt = K / BK;
    unsigned voffA[2], voffB[2];
#pragma unroll
    for (int i = 0; i < 2; ++i) { int R, C; stage_rc(tid * 16 + i * 8192, R, C); const int Rb = Epi::PERM ? ((R & ~31) + perm32(R & 31)) : R;
        voffA[i] = (unsigned)(R * K + C) * 2u; voffB[i] = (unsigned)(Rb * K + C) * 2u; }
    const size_t kstep = (size_t)(BK * 2);
    const size_t hstep = (size_t)HALF * K * 2;
    const size_t tstep = 2 * hstep;
    const unsigned ldsw = (unsigned)wid * 1024u;
    const int aoff = lds_byte(wr * 64 + fr, fq * 8), boff = lds_byte(wc * 32 + fr, fq * 8);
#define PG8_SA(b, h) (((b) * 2 + (h)) * HTB)
#define PG8_SB(b, h) ((4 + (b) * 2 + (h)) * HTB)
#define PG8_STAGE(bufoff, gbase, voff) do { _Pragma("unroll") for (int _i = 0; _i < 2; ++_i) \
        __builtin_amdgcn_global_load_lds((const unsigned*)((const char*)(gbase) + (voff)[_i]), (PG8_LAS unsigned*)(lds + (bufoff) + ldsw + _i * 8192), 16, 0, 0); } while (0)
#define PG8_LDA(dst, b, h) do { _Pragma("unroll") for (int m = 0; m < 4; ++m) _Pragma("unroll") for (int k = 0; k < 2; ++k) dst[m][k] = *(const PG8_LAS bf16x8*)(lds + PG8_SA(b, h) + aoff + m * 2048 + k * 1024); } while (0)
#define PG8_LDB(dst, b, h) do { _Pragma("unroll") for (int n = 0; n < 2; ++n) _Pragma("unroll") for (int k = 0; k < 2; ++k) dst[n][k] = *(const PG8_LAS bf16x8*)(lds + PG8_SB(b, h) + boff + n * 2048 + k * 1024); } while (0)
#define PG8_MMA(ai, bj, At, Bt) do { __builtin_amdgcn_s_setprio(1); _Pragma("unroll") for (int m = 0; m < 4; ++m) _Pragma("unroll") for (int n = 0; n < 2; ++n) _Pragma("unroll") for (int k = 0; k < 2; ++k) \
        acc[ai][bj][m][n] = __builtin_amdgcn_mfma_f32_16x16x32_bf16(Bt[n][k], At[m][k], acc[ai][bj][m][n], 0, 0, 0); __builtin_amdgcn_s_setprio(0); } while (0)
#define PG8_WAIT_V(n) asm volatile("s_waitcnt vmcnt(" #n ")" ::: "memory")
#define PG8_WAIT_L(n) asm volatile("s_waitcnt lgkmcnt(" #n ")" ::: "memory")
#define PG8_BAR __builtin_amdgcn_s_barrier()
#define PG8_SCHED __builtin_amdgcn_sched_barrier(0)
    Unit cur, nxt; int ui = 0;
    if (!S.next(0, cur)) return;
    f32x4 acc[2][2][4][2];
#pragma unroll
    for (int a = 0; a < 2; ++a)
#pragma unroll
        for (int b = 0; b < 2; ++b)
#pragma unroll
            for (int m = 0; m < 4; ++m)
#pragma unroll
                for (int n = 0; n < 2; ++n) acc[a][b][m][n] = (f32x4){0.f, 0.f, 0.f, 0.f};
    bf16x8 At[4][2], B0[2][2], B1[2][2];
    const char* cA = (const char*)g.A + (size_t)cur.pm * tstep; const char* cB = (const char*)g.Bt + (size_t)cur.pn * tstep;
    S.a_ready(cur);
    if constexpr (SP2) {
        PG8_STAGE(PG8_SB(0, 0), cB, voffB); PG8_STAGE(PG8_SB(0, 1), cB + hstep, voffB); PG8_STAGE(PG8_SA(0, 0), cA, voffA); PG8_STAGE(PG8_SA(0, 1), cA + hstep, voffA);
        if (wr == 1) PG8_BAR;
        PG8_WAIT_V(2); PG8_BAR;
        PG8_STAGE(PG8_SB(1, 0), cB + kstep, voffB); PG8_STAGE(PG8_SA(1, 0), cA + kstep, voffA); PG8_STAGE(PG8_SB(1, 1), cB + hstep + kstep, voffB);
        PG8_WAIT_V(6); PG8_BAR;
    } else {
        PG8_STAGE(PG8_SB(0, 0), cB, voffB); PG8_STAGE(PG8_SA(0, 0), cA, voffA); PG8_STAGE(PG8_SB(0, 1), cB + hstep, voffB); PG8_STAGE(PG8_SA(0, 1), cA + hstep, voffA);
        if (wr == 1) PG8_BAR;
        PG8_WAIT_V(4); PG8_BAR;
        PG8_STAGE(PG8_SB(1, 0), cB + kstep, voffB); PG8_STAGE(PG8_SA(1, 0), cA + kstep, voffA); PG8_STAGE(PG8_SB(1, 1), cB + hstep + kstep, voffB);
        PG8_WAIT_V(6); PG8_BAR;
    }
    for (;;) {
        const bool has_next = S.next(ui + 1, nxt);
        const char* nA = has_next ? (const char*)g.A + (size_t)nxt.pm * tstep : cA; const char* nB = has_next ? (const char*)g.Bt + (size_t)nxt.pn * tstep : cB;
        for (int t = 0; t < nt; t += 2) {
            const bool last = (t == nt - 2);
            const char* a1 = cA + (size_t)(t + 1) * kstep;
            const char* a2 = last ? nA : cA + (size_t)(t + 2) * kstep; const char* b2 = last ? nB : cB + (size_t)(t + 2) * kstep;
            const char* a3 = a2 + kstep; const char* b3 = b2 + kstep;
            if (last && has_next) S.a_ready(nxt);
            if constexpr (SP2) {
            PG8_LDB(B0, 0, 0); PG8_LDB(B1, 0, 1); PG8_SCHED; PG8_LDA(At, 0, 0); PG8_STAGE(PG8_SA(1, 1), a1 + hstep, voffA);
            PG8_WAIT_V(8); PG8_WAIT_L(0); PG8_BAR; PG8_MMA(0, 0, At, B0); PG8_MMA(0, 1, At, B1); PG8_BAR; PG8_SCHED;
            PG8_LDA(At, 0, 1); PG8_STAGE(PG8_SB(0, 0), b2, voffB); PG8_STAGE(PG8_SB(0, 1), b2 + hstep, voffB); PG8_STAGE(PG8_SA(0, 0), a2, voffA);
            PG8_WAIT_V(8); PG8_WAIT_L(0); PG8_BAR; PG8_MMA(1, 0, At, B0); PG8_MMA(1, 1, At, B1); PG8_BAR; PG8_SCHED;
            PG8_LDB(B0, 1, 0); PG8_LDB(B1, 1, 1); PG8_SCHED; PG8_LDA(At, 1, 0); PG8_STAGE(PG8_SA(0, 1), a2 + hstep, voffA);
            PG8_WAIT_V(8); PG8_WAIT_L(0); PG8_BAR; PG8_MMA(0, 0, At, B0); PG8_MMA(0, 1, At, B1); PG8_BAR; PG8_SCHED;
            PG8_LDA(At, 1, 1); PG8_STAGE(PG8_SB(1, 0), b3, voffB); PG8_STAGE(PG8_SB(1, 1), b3 + hstep, voffB); PG8_STAGE(PG8_SA(1, 0), a3, voffA);
            PG8_WAIT_V(8); PG8_WAIT_L(0); PG8_BAR; PG8_MMA(1, 0, At, B0); PG8_MMA(1, 1, At, B1); PG8_BAR; PG8_SCHED;
            } else {
            PG8_LDB(B0, 0, 0); PG8_SCHED; PG8_LDA(At, 0, 0); PG8_STAGE(PG8_SA(1, 1), a1 + hstep, voffA);
            PG8_WAIT_L(8); PG8_BAR; PG8_WAIT_L(0); PG8_MMA(0, 0, At, B0); PG8_BAR; PG8_SCHED;
            PG8_LDB(B1, 0, 1); PG8_STAGE(PG8_SB(0, 0), b2, voffB);
            PG8_BAR; PG8_WAIT_L(0); PG8_MMA(0, 1, At, B1); PG8_BAR;
            PG8_LDA(At, 0, 1); PG8_STAGE(PG8_SA(0, 0), a2, voffA);
            PG8_BAR; PG8_WAIT_L(0); PG8_MMA(1, 0, At, B0); PG8_BAR; PG8_SCHED;
            PG8_STAGE(PG8_SB(0, 1), b2 + hstep, voffB);
            PG8_WAIT_V(6); PG8_BAR; PG8_MMA(1, 1, At, B1); PG8_BAR;
            PG8_LDB(B0, 1, 0); PG8_SCHED; PG8_LDA(At, 1, 0); PG8_STAGE(PG8_SA(0, 1), a2 + hstep, voffA);
            PG8_WAIT_L(8); PG8_BAR; PG8_WAIT_L(0); PG8_MMA(0, 0, At, B0); PG8_BAR; PG8_SCHED;
            PG8_LDB(B1, 1, 1); PG8_STAGE(PG8_SB(1, 0), b3, voffB);
            PG8_BAR; PG8_WAIT_L(0); PG8_MMA(0, 1, At, B1); PG8_BAR;
            PG8_LDA(At, 1, 1); PG8_STAGE(PG8_SA(1, 0), a3, voffA);
            PG8_BAR; PG8_WAIT_L(0); PG8_MMA(1, 0, At, B0); PG8_BAR; PG8_SCHED;
            PG8_STAGE(PG8_SB(1, 1), b3 + hstep, voffB);
            PG8_WAIT_V(6); PG8_BAR; PG8_MMA(1, 1, At, B1); PG8_BAR;
            }
        }
        if constexpr (ALIGN_EPI) { if (wr == 0) PG8_BAR; }
        if constexpr (!Epi::AFTER_DRAIN) { E(acc, cur, wr, wc, fr, fq); S.done(cur); }
        if (!has_next) break;
#pragma unroll
        for (int a = 0; a < 2; ++a)
#pragma unroll
            for (int b = 0; b < 2; ++b)
#pragma unroll
                for (int m = 0; m < 4; ++m)
#pragma unroll
                    for (int n = 0; n < 2; ++n) acc[a][b][m][n] = (f32x4){0.f, 0.f, 0.f, 0.f};
        cur = nxt; cA = nA; cB = nB; ++ui;
        if constexpr (ALIGN_EPI) { if (wr == 1) PG8_BAR; }
    }
    PG8_WAIT_V(0);
    if constexpr (!ALIGN_EPI) { if (wr == 0) PG8_BAR; }
    PG8_BAR;
    if constexpr (Epi::AFTER_DRAIN) { E.fused(acc, cur, wr, wc, fr, fq, lds, wid, lane); S.done(cur); }
#undef PG8_SA
#undef PG8_SB
#undef PG8_STAGE
#undef PG8_LDA
#undef PG8_LDB
#undef PG8_MMA
#undef PG8_WAIT_V
#undef PG8_WAIT_L
#undef PG8_BAR
#undef PG8_SCHED
}
}
#define LAS __attribute__((address_space(3)))
typedef unsigned short bf16;
typedef float f32x4 __attribute__((ext_vector_type(4)));
typedef float f32x16 __attribute__((ext_vector_type(16)));
typedef unsigned u32x4 __attribute__((ext_vector_type(4)));
typedef unsigned u32x2 __attribute__((ext_vector_type(2)));
typedef short bf16x8 __attribute__((ext_vector_type(8)));

#ifndef FAST_SB
#define FAST_SB 1
#endif
#ifndef FAST_GLA
#define FAST_GLA 1
#endif

constexpr int NB = 16, S = 2048, D = 1024, M = NB * S, FF = 4096, NLAYER = 4;
constexpr int GLA_NA = 2304;
constexpr int PQ = 0, PK = 512, PG = 1024, PA1 = 2048;
constexpr float ALPHA = 1.681792830507429f, LN_EPS = 1e-5f, RMS_EPS = 1e-6f;
constexpr float C2_SB = 0.125f * 1.4426950408889634f;
constexpr size_t MiB = 1u << 20;
constexpr size_t WS_WA = 2 * MiB, WS_WV = 7 * MiB, WS_WO = 9 * MiB, WS_WUP = 12 * MiB, WS_WDN = 20 * MiB;
constexpr size_t WS_HB = 32 * MiB, WS_KB = 96 * MiB, WS_VT = 160 * MiB, WS_BIG = 224 * MiB, WS_END = 480 * MiB;
constexpr int LDS_BYTES = 155648;

struct Args { const float* in[13]; float* out; unsigned char* ws; };

__device__ __forceinline__ float bf2f(unsigned x) { return __uint_as_float(x << 16); }
__device__ __forceinline__ unsigned f2bf(float f) { unsigned u = __float_as_uint(f); return (u + 0x7fffu + ((u >> 16) & 1u)) >> 16; }
__device__ __forceinline__ unsigned pk2(float lo, float hi) { return f2bf(lo) | (f2bf(hi) << 16); }
__device__ __forceinline__ float wave_sum(float v) {
#pragma unroll
    for (int o = 1; o < 64; o <<= 1) v += __shfl_xor(v, o);
    return v;
}

namespace pg8 {
template <int ACT  > struct EpiB {
    static constexpr bool PERM = true, AFTER_DRAIN = false;
    bf16_t* O; int ldc; int split_cols; size_t split_stride; float scale0;
    __device__ __forceinline__ void operator()(const f32x4 (&acc)[2][2][4][2], const Unit& u, int wr, int wc, int fr, int fq) const {
        const int row0 = u.pm * BM + wr * 64 + fr; int colt = u.pn * BM; bf16_t* base = O;
        float sc = 1.f; if (split_cols) { const int t = colt / split_cols; base += (size_t)t * split_stride; colt -= t * split_cols; if (t == 0) sc = scale0; }
        const int col0 = colt + wc * 32 + 8 * fq;
#pragma unroll
        for (int ai = 0; ai < 2; ++ai)
#pragma unroll
            for (int m = 0; m < 4; ++m) { bf16_t* rowp = base + (size_t)(row0 + ai * HALF + m * 16) * ldc + col0;
#pragma unroll
                for (int bj = 0; bj < 2; ++bj) { f32x4 v0 = acc[ai][bj][m][0], v1 = acc[ai][bj][m][1];
                    if (ACT == 2) { v0 = __builtin_elementwise_max(v0, (f32x4){0.f, 0.f, 0.f, 0.f}); v1 = __builtin_elementwise_max(v1, (f32x4){0.f, 0.f, 0.f, 0.f}); v0 = v0 * v0; v1 = v1 * v1; }
                    v0 = v0 * sc; v1 = v1 * sc; u32x4 w; w.x = cvt_pk_bf16(v0[0], v0[1]); w.y = cvt_pk_bf16(v0[2], v0[3]); w.z = cvt_pk_bf16(v1[0], v1[1]); w.w = cvt_pk_bf16(v1[2], v1[3]);
                    *(u32x4*)(rowp + bj * HALF) = w; } }
    }
};
struct EpiRes {
    static constexpr bool PERM = false, AFTER_DRAIN = false;
    float* io; int ldc; float alpha;
    __device__ __forceinline__ void operator()(const f32x4 (&acc)[2][2][4][2], const Unit& u, int wr, int wc, int fr, int fq) const {
        const int col0 = u.pn * BM + wc * 32 + 4 * fq;
#pragma unroll
        for (int ai = 0; ai < 2; ++ai)
#pragma unroll
            for (int m = 0; m < 4; ++m) { float* rowp = io + (size_t)(u.pm * BM + ai * HALF + wr * 64 + m * 16 + fr) * ldc + col0;
#pragma unroll
                for (int bj = 0; bj < 2; ++bj)
#pragma unroll
                    for (int n = 0; n < 2; ++n) { f32x4* p = (f32x4*)(rowp + bj * HALF + n * 16); const f32x4 b = *p; *p = b * alpha + acc[ai][bj][m][n]; }
                asm volatile("" ::: "memory"); }
    }
};
}

__device__ __forceinline__ void transpose_item(const float* W, int ldw, int K, bf16* WT, LAS float* scr, int kb, int nb, int lane) {
    const int k0 = 64 * kb, n0 = 32 * nb;
#pragma unroll 8
    for (int i = 0; i < 32; ++i) { const int kk = 2 * i + (lane >> 5); scr[kk * 33 + (lane & 31)] = W[(size_t)(k0 + kk) * ldw + n0 + (lane & 31)]; }
    asm volatile("s_waitcnt lgkmcnt(0)" ::: "memory");
    const int c = lane & 7;
#pragma unroll
    for (int j = 0; j < 4; ++j) { const int n = (lane >> 3) + 8 * j; const LAS float* s = scr + (8 * c) * 33 + n;
        u32x4 o; o.x = pk2(s[0 * 33], s[1 * 33]); o.y = pk2(s[2 * 33], s[3 * 33]); o.z = pk2(s[4 * 33], s[5 * 33]); o.w = pk2(s[6 * 33], s[7 * 33]);
        *(u32x4*)(WT + (size_t)(n0 + n) * K + k0 + 8 * c) = o; }
    asm volatile("s_waitcnt lgkmcnt(0)" ::: "memory");
}
__device__ __forceinline__ void convert_job(const float* W, int ldw, int K, int ncols, bf16* WT, LAS float* scr, int gw, int NGW, int lane) {
    const int nblk = ncols / 32, nitems = (K / 64) * nblk;
    for (int it = gw; it < nitems; it += NGW) transpose_item(W, ldw, K, WT, scr, it / nblk, it % nblk, lane);
}
__device__ __forceinline__ void convert_layer(const Args& a, int L, LAS unsigned char* lds, int wave, int lane, int gw, int NGW) {
    LAS float* scr = (LAS float*)(lds + wave * 16384);
    unsigned char* ws = a.ws;
    bf16* WA = (bf16*)(ws + WS_WA); bf16* WV = (bf16*)(ws + WS_WV); bf16* WO = (bf16*)(ws + WS_WO); bf16* WUP = (bf16*)(ws + WS_WUP); bf16* WDN = (bf16*)(ws + WS_WDN);
    if (L < 2) {
        const float* win = a.in[1] + (size_t)L * D * 3088;
        convert_job(win + 0, 3088, D, 512, WA + (size_t)PQ * D, scr, gw, NGW, lane);
        convert_job(win + 512, 3088, D, 512, WA + (size_t)PK * D, scr, gw, NGW, lane);
        convert_job(win + 2048, 3088, D, 1024, WA + (size_t)PG * D, scr, gw, NGW, lane);
        convert_job(win + 1024, 3088, D, 1024, WV, scr, gw, NGW, lane);
        convert_job(a.in[5] + (size_t)L * D * D, D, D, D, WO, scr, gw, NGW, lane);
        const int gt = gw * 64 + lane, NT = NGW * 64;
        for (int idx = gt; idx < 16 * D; idx += NT) { const int n = idx / D, k = idx % D; WA[(size_t)(PA1 + n) * D + k] = (bf16)f2bf(win[(size_t)k * 3088 + 3072 + n]); }
        for (int idx = gt; idx < 240 * D / 8; idx += NT) ((u32x4*)(WA + (size_t)(PA1 + 16) * D))[idx] = (u32x4){0u, 0u, 0u, 0u};
    } else {
        const int j = L - 2;
        convert_job(a.in[7] + (size_t)j * D * D, D, D, D, WA, scr, gw, NGW, lane);
        if (j == 0) {
            convert_job(a.in[6] + 0, 2 * D, D, D, WA + (size_t)D * D, scr, gw, NGW, lane);
            convert_job(a.in[6] + D, 2 * D, D, D, WV, scr, gw, NGW, lane);
        }
        convert_job(a.in[8] + (size_t)j * D * D, D, D, D, WO, scr, gw, NGW, lane);
    }
    convert_job(a.in[9] + (size_t)L * D * FF, FF, D, FF, WUP, scr, gw, NGW, lane);
    convert_job(a.in[10] + (size_t)L * FF * D, D, FF, D, WDN, scr, gw, NGW, lane);
}

__device__ __forceinline__ void ln_phase(float* hf, bf16* hb, const float* g, const float* b, int gw, int NGW, int lane) {
    f32x4 gv[4], bv[4];
#pragma unroll
    for (int j = 0; j < 4; ++j) { gv[j] = ((const f32x4*)g)[lane + 64 * j]; bv[j] = ((const f32x4*)b)[lane + 64 * j]; }
    for (int m = gw; m < M; m += NGW) {
        f32x4* xr = (f32x4*)(hf + (size_t)m * D) + lane;
        f32x4 v[4]; float s = 0.f;
#pragma unroll
        for (int j = 0; j < 4; ++j) { v[j] = xr[64 * j]; s += (v[j].x + v[j].y) + (v[j].z + v[j].w); }
        const float mean = wave_sum(s) * (1.f / D); float s2 = 0.f;
#pragma unroll
        for (int j = 0; j < 4; ++j) { v[j] = v[j] - mean; s2 += (v[j].x * v[j].x + v[j].y * v[j].y) + (v[j].z * v[j].z + v[j].w * v[j].w); }
        const float rstd = 1.f / sqrtf(wave_sum(s2) * (1.f / D) + LN_EPS);
        u32x2* o8 = (u32x2*)(hb + (size_t)m * D) + lane;
#pragma unroll
        for (int j = 0; j < 4; ++j) { const f32x4 y = v[j] * rstd * gv[j] + bv[j]; xr[64 * j] = y; o8[64 * j] = (u32x2){pk2(y.x, y.y), pk2(y.z, y.w)}; }
    }
}
__device__ __forceinline__ float log_sigmoid_f(float z) { return fminf(z, 0.f) - log1pf(expf(-fabsf(z))); }

__device__ __forceinline__ void sb_naive(const bf16* Q, const bf16* K, const bf16* VT, bf16* O, int gtid, int nthreads) {
    int it = 0;
#pragma unroll 1
    for (int base = 0; base < NB * 16 * S; base += nthreads, ++it) {
        const int task = base + gtid;
        const int bh = __builtin_amdgcn_readfirstlane(task / S), tt = task % S;
        const int t = (it & 1) ? (S - 1 - tt) : tt;
        const int b = bh >> 4, h = bh & 15;
        const int tt0 = __builtin_amdgcn_readfirstlane(tt & ~63);
        const int tmax = (it & 1) ? (S - 1 - tt0) : (tt0 | 63);
        float q[64], o[64];
        { const u32x4* qp = (const u32x4*)(Q + (size_t)(b * S + t) * D + h * 64);
#pragma unroll
          for (int i = 0; i < 8; ++i) { const u32x4 w = qp[i];
              q[8 * i + 0] = bf2f(w.x & 0xffffu); q[8 * i + 1] = bf2f(w.x >> 16); q[8 * i + 2] = bf2f(w.y & 0xffffu); q[8 * i + 3] = bf2f(w.y >> 16);
              q[8 * i + 4] = bf2f(w.z & 0xffffu); q[8 * i + 5] = bf2f(w.z >> 16); q[8 * i + 6] = bf2f(w.w & 0xffffu); q[8 * i + 7] = bf2f(w.w >> 16); } }
#pragma unroll
        for (int d = 0; d < 64; ++d) o[d] = 0.f;
        float P = 1.f;
#pragma unroll 1
        for (int s = tmax - 1; s >= 0; --s) {
            const u32x4* kp = (const u32x4*)(K + (size_t)(b * S + s) * D + h * 64);
            float z = 0.f;
#pragma unroll
            for (int i = 0; i < 8; ++i) { const u32x4 kw = kp[i];
                z += q[8 * i + 0] * bf2f(kw.x & 0xffffu); z += q[8 * i + 1] * bf2f(kw.x >> 16); z += q[8 * i + 2] * bf2f(kw.y & 0xffffu); z += q[8 * i + 3] * bf2f(kw.y >> 16);
                z += q[8 * i + 4] * bf2f(kw.z & 0xffffu); z += q[8 * i + 5] * bf2f(kw.z >> 16); z += q[8 * i + 6] * bf2f(kw.w & 0xffffu); z += q[8 * i + 7] * bf2f(kw.w >> 16); }
            const float e = (s < t) ? exp2f(fminf(z, 100.f)) : 0.f;
            const float r = 1.f / (1.f + e);
            P *= r; const float w = e * P;
            const bf16* vp = VT + (size_t)(h * 64) * M + b * S + s;
#pragma unroll
            for (int d = 0; d < 64; ++d) { o[d] += w * bf2f(vp[(size_t)d * M]); if ((d & 7) == 7) asm volatile("" ::: "memory"); }
        }
        u32x4* op = (u32x4*)(O + (size_t)(b * S + t) * D + h * 64);
#pragma unroll
        for (int i = 0; i < 8; ++i) op[i] = (u32x4){pk2(o[8 * i], o[8 * i + 1]), pk2(o[8 * i + 2], o[8 * i + 3]), pk2(o[8 * i + 4], o[8 * i + 5]), pk2(o[8 * i + 6], o[8 * i + 7])};
    }
}

__device__ __forceinline__ void gla_gate_naive(const bf16* PROJ, const float* wa2, const float* ba, float* A, int gtid, int nthreads) {
    for (int idx = gtid; idx < M * 512; idx += nthreads) {
        const int t = idx >> 9, c = idx & 511;
        float z = ba[c];
        const u32x4* ap = (const u32x4*)(PROJ + (size_t)t * GLA_NA + PA1);
        const u32x4 a0 = ap[0], a1 = ap[1];
        const unsigned aw[8] = {a0.x, a0.y, a0.z, a0.w, a1.x, a1.y, a1.z, a1.w};
#pragma unroll
        for (int r = 0; r < 8; ++r) { z += bf2f(aw[r] & 0xffffu) * wa2[(2 * r) * 512 + c]; z += bf2f(aw[r] >> 16) * wa2[(2 * r + 1) * 512 + c]; }
        A[idx] = expf(log_sigmoid_f(z) * (1.f / 16.f));
    }
}
__device__ __forceinline__ void gla_rec_naive(const bf16* PROJ, const float* A, const bf16* VT, float* OU, int gtid) {
    if (gtid >= NB * 4 * 256) return;
    const int bh = __builtin_amdgcn_readfirstlane(gtid >> 8), e = gtid & 255, b = bh >> 2, h = bh & 3;
    float st[128];
#pragma unroll
    for (int c = 0; c < 128; ++c) st[c] = 0.f;
    const bf16* vt = VT + (size_t)(h * 256 + e) * M + b * S;
    for (int t = 0; t < S; ++t) {
        const size_t row = (size_t)b * S + t;
        const u32x4* qp = (const u32x4*)(PROJ + row * GLA_NA + PQ + h * 128);
        const u32x4* kp = (const u32x4*)(PROJ + row * GLA_NA + PK + h * 128);
        const f32x4* ap = (const f32x4*)(A + row * 512 + h * 128);
        const float v = bf2f(vt[t]);
        float o = 0.f;
#pragma unroll
        for (int i = 0; i < 16; ++i) {
            const u32x4 qw = qp[i], kw = kp[i]; const f32x4 a0 = ap[2 * i], a1 = ap[2 * i + 1];
            const unsigned qa[4] = {qw.x, qw.y, qw.z, qw.w}, ka[4] = {kw.x, kw.y, kw.z, kw.w};
            const float aa[8] = {a0.x, a0.y, a0.z, a0.w, a1.x, a1.y, a1.z, a1.w};
#pragma unroll
            for (int j = 0; j < 4; ++j) {
                const int c = 8 * i + 2 * j;
                st[c] = aa[2 * j] * st[c] + bf2f(ka[j] & 0xffffu) * v;         o += bf2f(qa[j] & 0xffffu) * st[c];
                st[c + 1] = aa[2 * j + 1] * st[c + 1] + bf2f(ka[j] >> 16) * v; o += bf2f(qa[j] >> 16) * st[c + 1];
            }
        }
        OU[row * D + h * 256 + e] = o * 0.08838834764831845f;
    }
}
__device__ __forceinline__ void gla_norm_naive(const float* OU, const bf16* PROJ, const float* ng, bf16* O, int gw, int NGW, int lane) {
    const f32x4 g4 = ((const f32x4*)ng)[lane];
    for (int task = gw; task < M * 4; task += NGW) {
        const int t = task >> 2, h = task & 3;
        const f32x4 v = *(const f32x4*)(OU + (size_t)t * D + h * 256 + 4 * lane);
        const float ss = wave_sum((v.x * v.x + v.y * v.y) + (v.z * v.z + v.w * v.w));
        const float rstd = 1.f / sqrtf(ss * (1.f / 256.f) + RMS_EPS);
        const u32x2 gw2 = *(const u32x2*)(PROJ + (size_t)t * GLA_NA + PG + h * 256 + 4 * lane);
        const float gg[4] = {bf2f(gw2.x & 0xffffu), bf2f(gw2.x >> 16), bf2f(gw2.y & 0xffffu), bf2f(gw2.y >> 16)};
        float y[4];
#pragma unroll
        for (int i = 0; i < 4; ++i) y[i] = v[i] * rstd * g4[i] * (gg[i] / (1.f + expf(-gg[i])));
        *(u32x2*)(O + (size_t)t * D + h * 256 + 4 * lane) = (u32x2){pk2(y[0], y[1]), pk2(y[2], y[3])};
    }
}
constexpr int SBR = 144, SBT = 64 * SBR;
__device__ __forceinline__ void sb_unit(int b, int h, int qb, const bf16* Q, const bf16* K, const bf16* VT, bf16* O, LAS unsigned char* lds) {
    int tid_ = threadIdx.x; asm volatile("" : "+v"(tid_)); const int tid = tid_, lane = tid & 63, q = lane & 31, hi = lane >> 5, w = __builtin_amdgcn_readfirstlane(tid >> 6);
    const size_t rowbase = (size_t)b * S;
    const int t = 256 * qb + 32 * w + q;
    bf16x8 qf[4];
    { const bf16* qrow = Q + (rowbase + t) * D + h * 64 + 8 * hi;
#pragma unroll
      for (int ks = 0; ks < 4; ++ks) qf[ks] = *(const bf16x8*)(qrow + 16 * ks); }
    f32x16 o0, o1;
#pragma unroll
    for (int r = 0; r < 16; ++r) { o0[r] = 0.f; o1[r] = 0.f; }
    float carry = 1.f;
    const int NT = 4 * (qb + 1), jw = 4 * qb + (w >> 1);
    const int tl = 32 * (w & 1) + q;
    const int srow = tid >> 3, sch = tid & 7;
    const bf16* kg = K + (rowbase + srow) * D + h * 64 + sch * 8;
    const bf16* vg = VT + (size_t)(h * 64 + srow) * M + rowbase + sch * 8;
    const int soff = srow * SBR + sch * 16;
    const int pi = (q & 0x13) | ((q & 4) << 1) | ((q & 8) >> 1);
    const int koff = pi * SBR + hi * 16, voff = q * SBR + hi * 16;
    { const u32x4 kreg = *(const u32x4*)(kg + (size_t)(NT - 1) * 64 * D), vreg = *(const u32x4*)(vg + (NT - 1) * 64);
      const int bo = ((NT - 1) & 1) * SBT;
      *(LAS u32x4*)(lds + bo + soff) = kreg; *(LAS u32x4*)(lds + 2 * SBT + bo + soff) = vreg; }
#pragma unroll 1
    for (int j = NT - 1; j >= 0; --j) {
        const int bo = (j & 1) * SBT;
        __syncthreads();
        u32x4 kreg, vreg;
        if (j > 0) { kreg = *(const u32x4*)(kg + (size_t)(j - 1) * 64 * D); vreg = *(const u32x4*)(vg + (j - 1) * 64); }
        if (j <= jw) {
            const LAS unsigned char* kb = lds + bo + koff; const LAS unsigned char* vb = lds + 2 * SBT + bo + voff;
            f32x16 p[2];
#pragma unroll
            for (int r = 0; r < 16; ++r) { p[0][r] = 0.f; p[1][r] = 0.f; }
#pragma unroll
            for (int ks = 0; ks < 4; ++ks) {
                const bf16x8 a0 = *(const LAS bf16x8*)(kb + ks * 32), a1 = *(const LAS bf16x8*)(kb + 32 * SBR + ks * 32);
                p[0] = __builtin_amdgcn_mfma_f32_32x32x16_bf16(a0, qf[ks], p[0], 0, 0, 0);
                p[1] = __builtin_amdgcn_mfma_f32_32x32x16_bf16(a1, qf[ks], p[1], 0, 0, 0);
            }
            float e[2][16], Lc[2][16];
            const bool diag = (j == jw);
#pragma unroll
            for (int blk = 0; blk < 2; ++blk)
#pragma unroll
                for (int r = 0; r < 16; ++r) {
                    float ev = __builtin_amdgcn_exp2f(fminf(p[blk][r], 100.f));
                    const int kl = 32 * blk + 16 * (r >> 3) + 8 * hi + (r & 7);
                    if (diag && kl >= tl) ev = 0.f;
                    e[blk][r] = ev;
                    Lc[blk][r] = __builtin_amdgcn_rcpf(1.f + ev);
                }
#pragma unroll
            for (int blk = 0; blk < 2; ++blk)
#pragma unroll
                for (int a = 0; a < 2; ++a)
#pragma unroll
                    for (int i = 6; i >= 0; --i) Lc[blk][8 * a + i] *= Lc[blk][8 * a + i + 1];
            float Gl[4], Gh[4];
#pragma unroll
            for (int m = 0; m < 4; ++m) { const unsigned gx = __float_as_uint(Lc[m >> 1][8 * (m & 1)]);
                auto rr = __builtin_amdgcn_permlane32_swap(gx, gx, false, false); Gl[m] = __uint_as_float(rr[0]); Gh[m] = __uint_as_float(rr[1]); }
            float Town[4]; float T = carry;
#pragma unroll
            for (int m = 3; m >= 0; --m) { const float Th = T; const float Tl = Th * Gh[m]; Town[m] = hi ? Th : Tl; T = Tl * Gl[m]; }
            carry = T;
            bf16x8 wp[4];
#pragma unroll
            for (int m = 0; m < 4; ++m) {
                const int blk = m >> 1, a = m & 1; float wv[8];
#pragma unroll
                for (int i = 0; i < 8; ++i) wv[i] = e[blk][8 * a + i] * Lc[blk][8 * a + i] * Town[m];
                u32x4 pk; pk.x = pg8::cvt_pk_bf16(wv[0], wv[1]); pk.y = pg8::cvt_pk_bf16(wv[2], wv[3]); pk.z = pg8::cvt_pk_bf16(wv[4], wv[5]); pk.w = pg8::cvt_pk_bf16(wv[6], wv[7]);
                wp[m] = __builtin_bit_cast(bf16x8, pk);
            }
#pragma unroll
            for (int m = 0; m < 4; ++m) {
                const bf16x8 v0 = *(const LAS bf16x8*)(vb + m * 32), v1 = *(const LAS bf16x8*)(vb + 32 * SBR + m * 32);
                o0 = __builtin_amdgcn_mfma_f32_32x32x16_bf16(v0, wp[m], o0, 0, 0, 0);
                o1 = __builtin_amdgcn_mfma_f32_32x32x16_bf16(v1, wp[m], o1, 0, 0, 0);
            }
        }
        if (j > 0) { const int bn = ((j - 1) & 1) * SBT; *(LAS u32x4*)(lds + bn + soff) = kreg; *(LAS u32x4*)(lds + 2 * SBT + bn + soff) = vreg; }
    }
    bf16* orow = O + (rowbase + t) * D + h * 64 + 4 * hi;
#pragma unroll
    for (int g = 0; g < 4; ++g) {
        *(u32x2*)(orow + 8 * g) = (u32x2){pg8::cvt_pk_bf16(o0[4 * g], o0[4 * g + 1]), pg8::cvt_pk_bf16(o0[4 * g + 2], o0[4 * g + 3])};
        *(u32x2*)(orow + 32 + 8 * g) = (u32x2){pg8::cvt_pk_bf16(o1[4 * g], o1[4 * g + 1]), pg8::cvt_pk_bf16(o1[4 * g + 2], o1[4 * g + 3])};
    }
    __syncthreads();
}
__device__ __forceinline__ void sb_phase(const bf16* Q, const bf16* K, const bf16* VT, bf16* O, LAS unsigned char* lds) {
    for (int bh = blockIdx.x; bh < NB * 16; bh += gridDim.x)
#pragma unroll 1
        for (int qb = 7; qb >= 0; --qb) sb_unit(bh >> 4, bh & 15, qb, Q, K, VT, O, lds);
}
constexpr int L_QD = 0, L_KD = 17408, L_KE = 34816, L_VT = 53248, L_ATT = 90112, L_LA = 99328, L_TOT = 133120, L_DEC = 135168, L_NG = 135680, L_GLA_END = 136704;
static_assert(L_GLA_END <= LDS_BYTES, "GLA LDS map");
__device__ __forceinline__ bf16x8 pack8(float a0, float a1, float a2, float a3, float a4, float a5, float a6, float a7) {
    u32x4 pk; pk.x = pg8::cvt_pk_bf16(a0, a1); pk.y = pg8::cvt_pk_bf16(a2, a3); pk.z = pg8::cvt_pk_bf16(a4, a5); pk.w = pg8::cvt_pk_bf16(a6, a7);
    return __builtin_bit_cast(bf16x8, pk);
}
template <bool OUT>
__device__ __forceinline__ void gla_unit(int b, int h, int seg, const bf16* PROJ, const bf16* VT, const float* wa2, const float* ba, const float* ng,
                                         float* USEG, float* DSEG, bf16* O, LAS unsigned char* lds) {
    int tid_ = threadIdx.x; asm volatile("" : "+v"(tid_)); const int tid = tid_, lane = tid & 63, l31 = lane & 31, hi = lane >> 5, w = __builtin_amdgcn_readfirstlane(tid >> 6);
    const int unit = (b * 4 + h) * 4 + seg;
    const int pi = (l31 & 0x13) | ((l31 & 4) << 1) | ((l31 & 8) >> 1);
    LAS bf16* QD16 = (LAS bf16*)(lds + L_QD); LAS bf16* KD16 = (LAS bf16*)(lds + L_KD);
    LAS float* LA = (LAS float*)(lds + L_LA); LAS float* TOT = (LAS float*)(lds + L_TOT); LAS float* DEC = (LAS float*)(lds + L_DEC); LAS float* NG = (LAS float*)(lds + L_NG);
    const int g_tb = w >> 2, g_cb = w & 3;
    bf16x8 wa2f; float ba_c;
    { const int c = h * 128 + 32 * g_cb + l31; float wv[8];
#pragma unroll
      for (int i = 0; i < 8; ++i) wv[i] = wa2[(8 * hi + i) * 512 + c];
      wa2f = pack8(wv[0], wv[1], wv[2], wv[3], wv[4], wv[5], wv[6], wv[7]); ba_c = ba[c]; }
    if (OUT && tid < 256) NG[tid] = ng[tid];
    f32x16 Sacc[4];
#pragma unroll
    for (int i = 0; i < 4; ++i)
#pragma unroll
        for (int r = 0; r < 16; ++r) Sacc[i][r] = 0.f;
    if (OUT) {
#pragma unroll 1
        for (int sp = 0; sp < seg; ++sp) {
            const int us = (b * 4 + h) * 4 + sp;
#pragma unroll
            for (int i = 0; i < 4; ++i)
#pragma unroll
                for (int r = 0; r < 16; ++r) { const int dk = 32 * i + 16 * (r >> 3) + 8 * hi + (r & 7);
                    Sacc[i][r] = DSEG[us * 128 + dk] * Sacc[i][r] + USEG[((size_t)us * 128 + dk) * 256 + 32 * w + l31]; }
        }
    }
    const int gc = tid & 127, gqd = tid >> 7;
    float dlog = 0.f;
#pragma unroll 1
    for (int n = 0; n < 8; ++n) {
        const size_t r0 = (size_t)b * S + seg * 512 + n * 64;
        {
#pragma unroll
            for (int i = 0; i < 2; ++i) { const int idx = tid + 512 * i, row = idx >> 4, ch = idx & 15;
                if (OUT) { const u32x4 qv = *(const u32x4*)(PROJ + (r0 + row) * GLA_NA + PQ + h * 128 + ch * 8); *(LAS u32x4*)(lds + L_QD + row * 272 + ch * 16) = qv; }
                const u32x4 kv = *(const u32x4*)(PROJ + (r0 + row) * GLA_NA + PK + h * 128 + ch * 8); *(LAS u32x4*)(lds + L_KD + row * 272 + ch * 16) = kv; }
#pragma unroll
            for (int i = 0; i < 4; ++i) { const int idx = tid + 512 * i, row = idx >> 3, ch = idx & 7;
                const u32x4 vv = *(const u32x4*)(VT + (size_t)(h * 256 + row) * M + r0 + ch * 8); *(LAS u32x4*)(lds + L_VT + row * 144 + ch * 16) = vv; }
        }
        {
            const bf16x8 af = *(const bf16x8*)(PROJ + (r0 + 32 * g_tb + l31) * GLA_NA + PA1 + 8 * hi);
            f32x16 z;
#pragma unroll
            for (int r = 0; r < 16; ++r) z[r] = 0.f;
            z = __builtin_amdgcn_mfma_f32_32x32x16_bf16(af, wa2f, z, 0, 0, 0);
#pragma unroll
            for (int r = 0; r < 16; ++r) { const float zz = z[r] + ba_c; const float ls = fminf(zz, 0.f) - __logf(1.f + __expf(-fabsf(zz)));
                const int t = 32 * g_tb + (r & 3) + 8 * (r >> 2) + 4 * hi; LA[t * 128 + 32 * g_cb + l31] = ls * (1.f / 16.f); }
        }
        __syncthreads();
        float bl[16];
        { float run = 0.f;
#pragma unroll
          for (int i = 0; i < 16; ++i) { run += LA[(16 * gqd + i) * 128 + gc]; bl[i] = run; }
          TOT[gqd * 128 + gc] = run; }
        __syncthreads();
        {
            float off = 0.f, blast = 0.f;
#pragma unroll
            for (int qq = 0; qq < 4; ++qq) { const float v = TOT[qq * 128 + gc]; blast += v; if (qq < gqd) off += v; }
            float ke[16];
#pragma unroll
            for (int i = 0; i < 16; ++i) { const float bb = off + bl[i]; const int t = 16 * gqd + i;
                const float kraw = bf2f(KD16[t * 136 + gc]);
                if (OUT) { const float qraw = bf2f(QD16[t * 136 + gc]);
                    QD16[t * 136 + gc] = (bf16)f2bf(qraw * 0.08838834764831845f * __expf(bb)); KD16[t * 136 + gc] = (bf16)f2bf(kraw * __expf(-bb)); }
                ke[i] = kraw * __expf(blast - bb); }
            *(LAS bf16x8*)(lds + L_KE + gc * 144 + 32 * gqd) = pack8(ke[0], ke[1], ke[2], ke[3], ke[4], ke[5], ke[6], ke[7]);
            *(LAS bf16x8*)(lds + L_KE + gc * 144 + 32 * gqd + 16) = pack8(ke[8], ke[9], ke[10], ke[11], ke[12], ke[13], ke[14], ke[15]);
            if (gqd == 0) { DEC[gc] = __expf(blast); dlog += blast; }
        }
        __syncthreads();
        if (OUT) {
            if (w < 4) {
                const int tb = w >> 1, sb = w & 1; const int srow = 32 * sb + pi, trow = 32 * tb + l31;
                f32x16 c;
#pragma unroll
                for (int r = 0; r < 16; ++r) c[r] = 0.f;
#pragma unroll
                for (int ks = 0; ks < 8; ++ks) {
                    const bf16x8 ak = *(const LAS bf16x8*)(lds + L_KD + srow * 272 + ks * 32 + hi * 16), bq = *(const LAS bf16x8*)(lds + L_QD + trow * 272 + ks * 32 + hi * 16);
                    c = __builtin_amdgcn_mfma_f32_32x32x16_bf16(ak, bq, c, 0, 0, 0);
                }
#pragma unroll
                for (int a = 0; a < 2; ++a) { float v[8];
#pragma unroll
                    for (int i = 0; i < 8; ++i) { const int s = 32 * sb + 16 * a + 8 * hi + i; v[i] = (s <= trow) ? c[8 * a + i] : 0.f; }
                    *(LAS bf16x8*)(lds + L_ATT + trow * 144 + (32 * sb + 16 * a + 8 * hi) * 2) = pack8(v[0], v[1], v[2], v[3], v[4], v[5], v[6], v[7]); }
            }
            __syncthreads();
        }
        bf16x8 vfrag[4];
#pragma unroll
        for (int ks = 0; ks < 4; ++ks) vfrag[ks] = *(const LAS bf16x8*)(lds + L_VT + (32 * w + l31) * 144 + ks * 32 + hi * 16);
        f32x16 Oa[2];
        if (OUT) {
#pragma unroll
            for (int r = 0; r < 16; ++r) { Oa[0][r] = 0.f; Oa[1][r] = 0.f; }
#pragma unroll
            for (int i = 0; i < 4; ++i)
#pragma unroll
                for (int a = 0; a < 2; ++a) {
                    const bf16x8 sb16 = pack8(Sacc[i][8 * a], Sacc[i][8 * a + 1], Sacc[i][8 * a + 2], Sacc[i][8 * a + 3], Sacc[i][8 * a + 4], Sacc[i][8 * a + 5], Sacc[i][8 * a + 6], Sacc[i][8 * a + 7]);
#pragma unroll
                    for (int tb = 0; tb < 2; ++tb) { const bf16x8 aq = *(const LAS bf16x8*)(lds + L_QD + (32 * tb + l31) * 272 + (32 * i + 16 * a) * 2 + hi * 16);
                        Oa[tb] = __builtin_amdgcn_mfma_f32_32x32x16_bf16(aq, sb16, Oa[tb], 0, 0, 0); }
                    __builtin_amdgcn_sched_barrier(0);
                }
#pragma unroll
            for (int ks = 0; ks < 4; ++ks)
#pragma unroll
                for (int tb = 0; tb < 2; ++tb) { const bf16x8 aa = *(const LAS bf16x8*)(lds + L_ATT + (32 * tb + l31) * 144 + ks * 32 + hi * 16);
                    Oa[tb] = __builtin_amdgcn_mfma_f32_32x32x16_bf16(aa, vfrag[ks], Oa[tb], 0, 0, 0); }
            __builtin_amdgcn_sched_barrier(0);
        }
#pragma unroll
        for (int i = 0; i < 4; ++i) {
#pragma unroll
            for (int a = 0; a < 2; ++a) { const f32x4 d0 = *(const LAS f32x4*)(lds + L_DEC + (32 * i + 16 * a + 8 * hi) * 4), d1 = *(const LAS f32x4*)(lds + L_DEC + (32 * i + 16 * a + 8 * hi) * 4 + 16);
#pragma unroll
                for (int e = 0; e < 4; ++e) { Sacc[i][8 * a + e] *= d0[e]; Sacc[i][8 * a + 4 + e] *= d1[e]; } }
#pragma unroll
            for (int ks = 0; ks < 4; ++ks) { const bf16x8 ak = *(const LAS bf16x8*)(lds + L_KE + (32 * i + pi) * 144 + ks * 32 + hi * 16);
                Sacc[i] = __builtin_amdgcn_mfma_f32_32x32x16_bf16(ak, vfrag[ks], Sacc[i], 0, 0, 0); }
            __builtin_amdgcn_sched_barrier(0);
        }
        if (OUT) {
            LAS bf16* OST = (LAS bf16*)(lds + L_LA);
#pragma unroll
            for (int tb = 0; tb < 2; ++tb)
#pragma unroll
                for (int r = 0; r < 16; ++r) { const int t = 32 * tb + (r & 3) + 8 * (r >> 2) + 4 * hi; OST[t * 264 + 32 * w + l31] = (bf16)f2bf(Oa[tb][r]); }
            __syncthreads();
            const int t = tid >> 3, j = tid & 7;
            u32x4 ov[4]; float ss = 0.f;
#pragma unroll
            for (int i = 0; i < 4; ++i) { ov[i] = *(const LAS u32x4*)(lds + L_LA + t * 528 + (8 * j + 64 * i) * 2);
                const unsigned ww[4] = {ov[i].x, ov[i].y, ov[i].z, ov[i].w};
#pragma unroll
                for (int e = 0; e < 4; ++e) { const float lo = bf2f(ww[e] & 0xffffu), hh = bf2f(ww[e] >> 16); ss += lo * lo + hh * hh; } }
            ss += __shfl_xor(ss, 1); ss += __shfl_xor(ss, 2); ss += __shfl_xor(ss, 4);
            const float rstd = 1.f / sqrtf(ss * (1.f / 256.f) + RMS_EPS);
#pragma unroll
            for (int i = 0; i < 4; ++i) { const int dv0 = 8 * j + 64 * i;
                const u32x4 g8 = *(const u32x4*)(PROJ + (r0 + t) * GLA_NA + PG + h * 256 + dv0);
                const f32x4 n0 = *(const LAS f32x4*)(lds + L_NG + dv0 * 4), n1 = *(const LAS f32x4*)(lds + L_NG + dv0 * 4 + 16);
                const unsigned ww[4] = {ov[i].x, ov[i].y, ov[i].z, ov[i].w}, gg[4] = {g8.x, g8.y, g8.z, g8.w};
                const float nn[8] = {n0.x, n0.y, n0.z, n0.w, n1.x, n1.y, n1.z, n1.w};
                float y[8];
#pragma unroll
                for (int e = 0; e < 4; ++e) { const float o0 = bf2f(ww[e] & 0xffffu), o1 = bf2f(ww[e] >> 16), g0 = bf2f(gg[e] & 0xffffu), g1 = bf2f(gg[e] >> 16);
                    y[2 * e] = o0 * rstd * nn[2 * e] * (g0 / (1.f + __expf(-g0))); y[2 * e + 1] = o1 * rstd * nn[2 * e + 1] * (g1 / (1.f + __expf(-g1))); }
                *(u32x4*)(O + (r0 + t) * D + h * 256 + dv0) = (u32x4){pk2(y[0], y[1]), pk2(y[2], y[3]), pk2(y[4], y[5]), pk2(y[6], y[7])}; }
        }
        __syncthreads();
    }
    if (!OUT) {
#pragma unroll
        for (int i = 0; i < 4; ++i)
#pragma unroll
            for (int r = 0; r < 16; ++r) { const int dk = 32 * i + 16 * (r >> 3) + 8 * hi + (r & 7); USEG[((size_t)unit * 128 + dk) * 256 + 32 * w + l31] = Sacc[i][r]; }
        if (gqd == 0) DSEG[unit * 128 + gc] = __expf(dlog);
    }
    __syncthreads();
}
template <int L> __device__ __forceinline__ void run_layer(const Args& a, cg::grid_group& grid, LAS unsigned char* lds) {
    int tid_ = threadIdx.x; asm volatile("" : "+v"(tid_)); const int tid = tid_, lane = tid & 63, wave = __builtin_amdgcn_readfirstlane(tid >> 6);
    const int G = gridDim.x, gw = blockIdx.x * 8 + wave, NGW = G * 8, gtid = blockIdx.x * 512 + tid, NTH = G * 512;
    unsigned char* ws = a.ws;
    bf16* WA = (bf16*)(ws + WS_WA); bf16* WV = (bf16*)(ws + WS_WV); bf16* WO = (bf16*)(ws + WS_WO); bf16* WUP = (bf16*)(ws + WS_WUP); bf16* WDN = (bf16*)(ws + WS_WDN);
    bf16* HB = (bf16*)(ws + WS_HB); bf16* KB = (bf16*)(ws + WS_KB); bf16* VT = (bf16*)(ws + WS_VT); bf16* BIG = (bf16*)(ws + WS_BIG);
    float* HF = a.out;
    (void)gtid; (void)NTH; (void)WV; (void)KB;
        bf16* OB;
        if constexpr (L < 2) {
            bf16* PROJ = BIG;
            { pg8::Gemm g{HB, WA, M, GLA_NA, D}; pg8::StaticOrder So; So.init(M, GLA_NA, G, (int)blockIdx.x);
              pg8::EpiB<0> E{PROJ, GLA_NA, 0, 0, 1.f};
              pg8::gemm_phase<pg8::EpiB<0>, pg8::StaticOrder, true, true>(lds, g, So, E); }
            { pg8::Gemm g{WV, HB, D, M, D}; pg8::StaticOrder So; So.init(D, M, G, (int)blockIdx.x);
              pg8::EpiB<0> E{VT, M, 0, 0, 1.f};
              pg8::gemm_phase<pg8::EpiB<0>, pg8::StaticOrder, true, true>(lds, g, So, E); }
            grid.sync();
            const float* wa2 = a.in[2] + (size_t)L * 16 * 512; const float* ba = a.in[3] + (size_t)L * 512; const float* ng = a.in[4] + (size_t)L * 256;
#if FAST_GLA
            OB = KB;
            { float* USEG = (float*)(ws + WS_BIG + 144 * MiB); float* DSEG = (float*)(ws + WS_BIG + 176 * MiB);
              for (int u = blockIdx.x; u < NB * 16; u += G) if ((u & 3) < 3) gla_unit<false>(u >> 4, (u >> 2) & 3, u & 3, PROJ, VT, wa2, ba, ng, USEG, DSEG, OB, lds);
              grid.sync();
              for (int u = blockIdx.x; u < NB * 16; u += G) gla_unit<true>(u >> 4, (u >> 2) & 3, u & 3, PROJ, VT, wa2, ba, ng, USEG, DSEG, OB, lds); }
#else
            float* AG = (float*)(ws + WS_BIG + 144 * MiB); float* OU = (float*)(ws + WS_HB); OB = VT;
            gla_gate_naive(PROJ, wa2, ba, AG, gtid, NTH);
            grid.sync();
            gla_rec_naive(PROJ, AG, VT, OU, gtid);
            grid.sync();
            gla_norm_naive(OU, PROJ, ng, OB, gw, NGW, lane);
#endif
            grid.sync();
        } else {
            constexpr int j = L - 2;
            bf16* QB = BIG; OB = BIG + (size_t)M * D;
            { const int N = (j == 0) ? 2 * D : D;
              pg8::Gemm g{HB, WA, M, N, D}; pg8::StaticOrder So; So.init(M, N, G, (int)blockIdx.x);
              pg8::EpiB<0> E{QB, D, D, (size_t)(KB - QB), C2_SB};
              pg8::gemm_phase<pg8::EpiB<0>, pg8::StaticOrder, true, true>(lds, g, So, E); }
            if constexpr (j == 0) { pg8::Gemm g{WV, HB, D, M, D}; pg8::StaticOrder So; So.init(D, M, G, (int)blockIdx.x);
              pg8::EpiB<0> E{VT, M, 0, 0, 1.f};
              pg8::gemm_phase<pg8::EpiB<0>, pg8::StaticOrder, true, true>(lds, g, So, E); }
            grid.sync();
#if FAST_SB
            sb_phase(QB, KB, VT, OB, lds);
#else
            sb_naive(QB, KB, VT, OB, gtid, NTH);
#endif
            grid.sync();
        }
        { pg8::Gemm g{OB, WO, M, D, D}; pg8::StaticOrder So; So.init(M, D, G, (int)blockIdx.x);
          pg8::EpiRes E{HF, D, ALPHA};
          pg8::gemm_phase<pg8::EpiRes, pg8::StaticOrder, true, true>(lds, g, So, E); }
        grid.sync();
        ln_phase(HF, HB, a.in[11] + (size_t)(L * 2 + 0) * D, a.in[12] + (size_t)(L * 2 + 0) * D, gw, NGW, lane);
        grid.sync();
        { pg8::Gemm g{HB, WUP, M, FF, D}; pg8::StaticOrder So; So.init(M, FF, G, (int)blockIdx.x);
          pg8::EpiB<2> E{BIG, FF, 0, 0, 1.f};
          pg8::gemm_phase<pg8::EpiB<2>, pg8::StaticOrder, true, true>(lds, g, So, E); }
        grid.sync();
        { pg8::Gemm g{BIG, WDN, M, D, FF}; pg8::StaticOrder So; So.init(M, D, G, (int)blockIdx.x);
          pg8::EpiRes E{HF, D, ALPHA};
          pg8::gemm_phase<pg8::EpiRes, pg8::StaticOrder, true, true>(lds, g, So, E); }
        grid.sync();
        ln_phase(HF, HB, a.in[11] + (size_t)(L * 2 + 1) * D, a.in[12] + (size_t)(L * 2 + 1) * D, gw, NGW, lane);
        if constexpr (L + 1 < NLAYER) { convert_layer(a, L + 1, lds, wave, lane, gw, NGW); grid.sync(); }
}

__global__ void __launch_bounds__(512, 2) yoco_fwd(Args a) {
    extern __shared__ __attribute__((aligned(16))) unsigned char lds_raw[];
    cg::grid_group grid = cg::this_grid();
    LAS unsigned char* lds = (LAS unsigned char*)lds_raw;
    int tid_ = threadIdx.x; asm volatile("" : "+v"(tid_)); const int tid = tid_, lane = tid & 63, wave = __builtin_amdgcn_readfirstlane(tid >> 6);
    const int G = gridDim.x, gw = blockIdx.x * 8 + wave, NGW = G * 8, gtid = blockIdx.x * 512 + tid, NTH = G * 512;
    unsigned char* ws = a.ws;
    bf16* WA = (bf16*)(ws + WS_WA); bf16* WV = (bf16*)(ws + WS_WV); bf16* WO = (bf16*)(ws + WS_WO); bf16* WUP = (bf16*)(ws + WS_WUP); bf16* WDN = (bf16*)(ws + WS_WDN);
    bf16* HB = (bf16*)(ws + WS_HB); bf16* KB = (bf16*)(ws + WS_KB); bf16* VT = (bf16*)(ws + WS_VT); bf16* BIG = (bf16*)(ws + WS_BIG);
    float* HF = a.out;

    convert_layer(a, 0, lds, wave, lane, gw, NGW);
    { const f32x4* xs = (const f32x4*)a.in[0]; f32x4* hd = (f32x4*)HF; u32x2* hb = (u32x2*)HB;
      for (int i = gtid; i < M * D / 4; i += NTH) { const f32x4 v = xs[i]; hd[i] = v; hb[i] = (u32x2){pk2(v.x, v.y), pk2(v.z, v.w)}; } }
    grid.sync();

    run_layer<0>(a, grid, lds);
    run_layer<1>(a, grid, lds);
    run_layer<2>(a, grid, lds);
    run_layer<3>(a, grid, lds);
}

extern "C" void kernel_launch(void* const* d_in, const int* in_sizes, int n_in, void* d_out, int out_size, void* d_ws, size_t ws_size, hipStream_t stream) {
    static int grid = 0;
    if (grid == 0) {
        if (n_in != 13 || out_size != M * D || ws_size < WS_END) { fprintf(stderr, "kernel_launch: unexpected shapes (n_in %d out %d ws %zu)\n", n_in, out_size, ws_size); grid = -1; return; }
        int dev = 0, cus = 0, per_cu = 0;
        hipGetDevice(&dev); hipDeviceGetAttribute(&cus, hipDeviceAttributeMultiprocessorCount, dev);
        hipFuncSetAttribute((const void*)yoco_fwd, hipFuncAttributeMaxDynamicSharedMemorySize, LDS_BYTES);
        hipOccupancyMaxActiveBlocksPerMultiprocessor(&per_cu, (const void*)yoco_fwd, 512, LDS_BYTES);
        if (per_cu < 1) { fprintf(stderr, "kernel_launch: occupancy query says %d blocks/CU\n", per_cu); per_cu = 1; }
        (void)hipGetLastError();
        grid = cus * 1;
    }
    if (grid < 0) return;
    Args a{};
    for (int i = 0; i < 13; ++i) a.in[i] = (const float*)d_in[i];
    a.out = (float*)d_out; a.ws = (unsigned char*)d_ws;
    void* args[] = {&a};
    hipError_t e = hipLaunchCooperativeKernel((const void*)yoco_fwd, dim3(grid), dim3(512), args, LDS_BYTES, stream);
    if (e != hipSuccess) fprintf(stderr, "cooperative launch failed: %s (grid %d)\n", hipGetErrorString(e), grid);
}
```
